# Optimizing an MI355X kernel written in HIP

```python
import math
import jax, jax.numpy as jnp
from jax import lax
import numpy as np

D_MODEL = 1024
BATCH = 8
SEQ = 2048
DEPTH = 4
DEC_BATCH = 128
DEC_SEQ = 4
PAST_LEN = 16384
PAGE_SIZE = 128

N_META = 16
D_RNN = D_MODEL
N_RNN_HEADS = 16
RNN_HEAD_DIM = D_RNN // N_RNN_HEADS
RNN_CONV_W = 4
LRU_C = 8.0
D_CONV = D_MODEL
N_CONV_GROUPS = 16
SC_CONV_W = 3
D_FF = int(math.ceil((8 * D_MODEL / 3) / 256) * 256)
EPS = 1e-6
SPLITS = (D_RNN, D_RNN, D_CONV, D_CONV, D_CONV, D_MODEL, D_MODEL)
D_IN = sum(SPLITS)

kernel_name = "hawk_shortconv_parallel_meta_decoder_step"


def rmsnorm(x, g):
    xf = x.astype(jnp.float32)
    y = xf * lax.rsqrt(jnp.mean(xf * xf, axis=-1, keepdims=True) + EPS)
    return (y * g.astype(jnp.float32)).astype(x.dtype)


def causal_dwconv(x, buf, w, b=None):
    width = w.shape[0]
    t = x.shape[1]
    xp = jnp.concatenate([buf.astype(x.dtype), x], axis=1)
    out = xp[:, 0:t] * w[0]
    for k in range(1, width):
        out = out + xp[:, k:k + t] * w[k]
    if b is not None:
        out = out + b
    return out, xp[:, xp.shape[1] - (width - 1):]


def rglru(x, h0, wa, ba, wx, bx, lam):
    bsz, t, _ = x.shape
    xh = x.reshape(bsz, t, N_RNN_HEADS, RNN_HEAD_DIM)
    r = jax.nn.sigmoid(jnp.einsum('bthi,hij->bthj', xh, wa).reshape(bsz, t, D_RNN).astype(jnp.float32) + ba.astype(jnp.float32))
    i = jax.nn.sigmoid(jnp.einsum('bthi,hij->bthj', xh, wx).reshape(bsz, t, D_RNN).astype(jnp.float32) + bx.astype(jnp.float32))
    log_a = -LRU_C * r * jax.nn.softplus(-lam.astype(jnp.float32))
    a = jnp.exp(log_a)
    mult = jnp.sqrt(jnp.maximum(-jnp.expm1(2.0 * log_a), 1e-12))
    u = mult * i * x.astype(jnp.float32)
    u = jnp.concatenate([u[:, :1] + a[:, :1] * h0.astype(jnp.float32)[:, None], u[:, 1:]], axis=1)

    def combine(left, right):
        a1, b1 = left
        a2, b2 = right
        return a1 * a2, a2 * b1 + b2

    _, h = lax.associative_scan(combine, (a, u), axis=1)
    return h, h[:, -1]


def trunk(x, h_st, rconv_st, sconv_st,
          norm1_g, w_in, rnn_conv_w, rnn_conv_b, gate_a_w, gate_a_b, gate_x_w, gate_x_b, lru_lambda,
          w_branch_a, sc_conv_w, w_branch_b, w_out, norm2_g, w_ff_gate, w_ff_up, w_ff_down, final_norm_g):
    dt = x.dtype
    offs = list(np.cumsum(SPLITS)[:-1])
    hs, rcs, scs = [], [], []
    for l in range(DEPTH):
        u = rmsnorm(x, norm1_g[l])
        p = u @ w_in[l]
        xr, gr, bc, cc, hc, ga, gb = jnp.split(p, offs, axis=-1)
        xr, new_rc = causal_dwconv(xr, rconv_st[l], rnn_conv_w[l], rnn_conv_b[l])
        hseq, h_last = rglru(xr, h_st[l], gate_a_w[l], gate_a_b[l], gate_x_w[l], gate_x_b[l], lru_lambda[l])
        ya = hseq.astype(dt) * jax.nn.gelu(gr)
        vc, new_sc = causal_dwconv(cc * hc, sconv_st[l], sc_conv_w[l])
        yb = bc * vc
        m = jax.nn.sigmoid(ga) * (ya @ w_branch_a[l]) + jax.nn.sigmoid(gb) * (yb @ w_branch_b[l])
        x = x + m @ w_out[l]
        v = rmsnorm(x, norm2_g[l])
        x = x + (jax.nn.silu(v @ w_ff_gate[l]) * (v @ w_ff_up[l])) @ w_ff_down[l]
        hs.append(h_last.astype(dt))
        rcs.append(new_rc)
        scs.append(new_sc)
    return rmsnorm(x, final_norm_g), jnp.stack(hs), jnp.stack(rcs), jnp.stack(scs)


def setup_inputs(seed: int = 0) -> dict:
    key = jax.random.key(seed)
    ks = jax.random.split(key, 32)
    f = jnp.float32
    nrm = lambda k, shape, s: jax.random.normal(k, shape, f) * s
    a8 = jax.random.uniform(ks[10], (DEPTH, D_RNN), f, 0.9, 0.999)
    a_base = a8 ** (1.0 / LRU_C)
    lru_lambda = jnp.log(a_base) - jnp.log1p(-a_base)
    return {
        "x_prompt": nrm(ks[0], (BATCH, SEQ, D_MODEL), 1.0),
        "x_sample": nrm(ks[1], (DEC_BATCH, DEC_SEQ, D_MODEL), 1.0),
        "state_rnn_h": nrm(ks[2], (DEPTH, DEC_BATCH, D_RNN), 0.5),
        "state_rnn_conv": nrm(ks[3], (DEPTH, DEC_BATCH, RNN_CONV_W - 1, D_RNN), 1.0),
        "state_sc_conv": nrm(ks[4], (DEPTH, DEC_BATCH, SC_CONV_W - 1, D_CONV), 1.0),
        "meta_tokens": nrm(ks[5], (N_META, D_MODEL), 1.0),
        "norm1_g": 1.0 + nrm(ks[6], (DEPTH, D_MODEL), 0.02),
        "w_in": nrm(ks[7], (DEPTH, D_MODEL, D_IN), D_MODEL ** -0.5),
        "rnn_conv_w": nrm(ks[8], (DEPTH, RNN_CONV_W, D_RNN), RNN_CONV_W ** -0.5),
        "rnn_conv_b": nrm(ks[9], (DEPTH, D_RNN), 0.02),
        "gate_a_w": nrm(ks[11], (DEPTH, N_RNN_HEADS, RNN_HEAD_DIM, RNN_HEAD_DIM), RNN_HEAD_DIM ** -0.5),
        "gate_a_b": nrm(ks[12], (DEPTH, D_RNN), 0.02),
        "gate_x_w": nrm(ks[13], (DEPTH, N_RNN_HEADS, RNN_HEAD_DIM, RNN_HEAD_DIM), RNN_HEAD_DIM ** -0.5),
        "gate_x_b": nrm(ks[14], (DEPTH, D_RNN), 0.02),
        "lru_lambda": lru_lambda,
        "w_branch_a": nrm(ks[15], (DEPTH, D_RNN, D_MODEL), D_RNN ** -0.5),
        "sc_conv_w": nrm(ks[16], (DEPTH, SC_CONV_W, D_CONV), SC_CONV_W ** -0.5),
        "w_branch_b": nrm(ks[17], (DEPTH, D_CONV, D_MODEL), D_CONV ** -0.5),
        "w_out": nrm(ks[18], (DEPTH, D_MODEL, D_MODEL), D_MODEL ** -0.5),
        "norm2_g": 1.0 + nrm(ks[19], (DEPTH, D_MODEL), 0.02),
        "w_ff_gate": nrm(ks[20], (DEPTH, D_MODEL, D_FF), D_MODEL ** -0.5),
        "w_ff_up": nrm(ks[21], (DEPTH, D_MODEL, D_FF), D_MODEL ** -0.5),
        "w_ff_down": nrm(ks[22], (DEPTH, D_FF, D_MODEL), D_FF ** -0.5),
        "final_norm_g": 1.0 + nrm(ks[23], (D_MODEL,), 0.02),
    }


def reference(x_prompt, x_sample, state_rnn_h, state_rnn_conv, state_sc_conv, meta_tokens,
              norm1_g, w_in, rnn_conv_w, rnn_conv_b, gate_a_w, gate_a_b, gate_x_w, gate_x_b, lru_lambda,
              w_branch_a, sc_conv_w, w_branch_b, w_out, norm2_g, w_ff_gate, w_ff_up, w_ff_down, final_norm_g):
    weights = (norm1_g, w_in, rnn_conv_w, rnn_conv_b, gate_a_w, gate_a_b, gate_x_w, gate_x_b, lru_lambda,
               w_branch_a, sc_conv_w, w_branch_b, w_out, norm2_g, w_ff_gate, w_ff_up, w_ff_down, final_norm_g)
    bp = x_prompt.shape[0]
    dt = x_prompt.dtype
    meta = jnp.broadcast_to(meta_tokens.astype(dt)[None], (bp, N_META, D_MODEL))
    xp = jnp.concatenate([meta, x_prompt], axis=1)
    h0 = jnp.zeros((DEPTH, bp, D_RNN), dt)
    rc0 = jnp.zeros((DEPTH, bp, RNN_CONV_W - 1, D_RNN), dt)
    sc0 = jnp.zeros((DEPTH, bp, SC_CONV_W - 1, D_CONV), dt)
    yp, rnn_h_prompt, rnn_conv_prompt, sc_conv_prompt = trunk(xp, h0, rc0, sc0, *weights)
    y_prompt = yp[:, N_META:]
    y_sample, rnn_h_sample, rnn_conv_sample, sc_conv_sample = trunk(
        x_sample, state_rnn_h, state_rnn_conv, state_sc_conv, *weights)
    return (y_prompt, y_sample, rnn_h_prompt, rnn_conv_prompt, sc_conv_prompt,
            rnn_h_sample, rnn_conv_sample, sc_conv_sample)
```

```cpp
#include <hip/hip_runtime.h>
#include <hip/hip_cooperative_groups.h>
#include <cstdio>
namespace cg = cooperative_groups;

#define LAS __attribute__((address_space(3)))
typedef unsigned short bf16_t;
typedef short bf16x8 __attribute__((ext_vector_type(8)));
typedef float f32x4 __attribute__((ext_vector_type(4)));
typedef unsigned u32x4 __attribute__((ext_vector_type(4)));
typedef unsigned u32x2 __attribute__((ext_vector_type(2)));
typedef unsigned long long u64;

constexpr int D = 1024, DIN = 7168, DFF = 2816, DEPTH = 4;
constexpr int NSEQ = 8, SEQ = 2048, NDEC = 128, DECT = 4, NMETA = 16;
constexpr int SAMPLE_ROW0 = NSEQ * SEQ;
constexpr int META_ROW0 = SAMPLE_ROW0 + NDEC * DECT;
constexpr int MOUT = META_ROW0;
constexpr int MPAD = 17152;
constexpr float EPS = 1e-6f;
constexpr int NT = 512;
constexpr int LDS_BYTES = 128 * 1024;

constexpr size_t P_BYTES = (size_t)MPAD * DIN * 2;
constexpr size_t X_BYTES = (size_t)MPAD * D * 4;
constexpr size_t XB_BYTES = (size_t)MPAD * D * 2;
constexpr size_t W1_E = (size_t)DIN * D, WAB_E = (size_t)2048 * D, WO2_E = (size_t)D * 2048, WGU_E = (size_t)2 * DFF * D, WD_E = (size_t)D * DFF, WG_E = (size_t)16 * 128 * 64;
constexpr size_t WSET_E = W1_E + WAB_E + WO2_E + WGU_E + WD_E + WG_E;
constexpr size_t WSET_BYTES = WSET_E * 2;
constexpr int NSLOT = 1 + NSEQ * 32;
constexpr size_t AGG_BYTES = (size_t)DEPTH * NSLOT * D * 8;
constexpr size_t OFF_P = 0, OFF_X = OFF_P + P_BYTES, OFF_XB = OFF_X + X_BYTES, OFF_W = OFF_XB + XB_BYTES, OFF_RS1 = OFF_W + 2 * WSET_BYTES,
                 OFF_RS2 = OFF_RS1 + (size_t)MPAD * 64, OFF_AGG = OFF_RS2 + (size_t)MPAD * 64, WS_NEED = OFF_AGG + AGG_BYTES;

constexpr size_t O_Y = 0, O_HP = (size_t)MOUT * D, O_RCP = O_HP + (size_t)DEPTH * NSEQ * D, O_SCP = O_RCP + (size_t)DEPTH * NSEQ * 3 * D,
                 O_HS = O_SCP + (size_t)DEPTH * NSEQ * 2 * D, O_RCS = O_HS + (size_t)DEPTH * NDEC * D, O_SCS = O_RCS + (size_t)DEPTH * NDEC * 3 * D;

struct Params {
    const float* in[24];
    float* out;
    unsigned char* ws;
};

__device__ __forceinline__ unsigned cvt_pk_bf16(float lo, float hi) { unsigned r; asm volatile("v_cvt_pk_bf16_f32 %0, %1, %2" : "=v"(r) : "v"(lo), "v"(hi)); return r; }
__device__ __forceinline__ float bf_lo(unsigned w) { return __uint_as_float(w << 16); }
__device__ __forceinline__ float bf_hi(unsigned w) { return __uint_as_float(w & 0xffff0000u); }
__device__ __forceinline__ float bf2f(bf16_t b) { return __uint_as_float(((unsigned)b) << 16); }
__device__ __forceinline__ float sigmoidf_(float x) { return 1.0f / (1.0f + __expf(-x)); }
__device__ __forceinline__ void unpack8(const u32x4 w, float (&f)[8]) {
    f[0] = bf_lo(w.x); f[1] = bf_hi(w.x); f[2] = bf_lo(w.y); f[3] = bf_hi(w.y); f[4] = bf_lo(w.z); f[5] = bf_hi(w.z); f[6] = bf_lo(w.w); f[7] = bf_hi(w.w);
}
__device__ __forceinline__ u32x4 pack8(const float (&f)[8]) {
    u32x4 w; w.x = cvt_pk_bf16(f[0], f[1]); w.y = cvt_pk_bf16(f[2], f[3]); w.z = cvt_pk_bf16(f[4], f[5]); w.w = cvt_pk_bf16(f[6], f[7]); return w;
}

__device__ __forceinline__ float row_rs(const float* rsp, int row) {
    const f32x4 a = *(const f32x4*)(rsp + (size_t)row * 16), b = *(const f32x4*)(rsp + (size_t)row * 16 + 4), c = *(const f32x4*)(rsp + (size_t)row * 16 + 8), d = *(const f32x4*)(rsp + (size_t)row * 16 + 12);
    const f32x4 s = (a + b) + (c + d);
    return rsqrtf(((s[0] + s[1]) + (s[2] + s[3])) * (1.0f / D) + EPS);
}

namespace pg8 {
constexpr int BM = 256, BK = 64, HALF = 128, HTB = HALF * BK * 2, STAGE_BYTES = 8 * HTB, NXCD = 8, WGM = 8;
__device__ __forceinline__ int lds_byte(int r, int c) { const int st = (r >> 4) * 2 + (c >> 5), rr = r & 15, cc = c & 31, ob = rr * 64 + cc * 2; return st * 1024 + (ob ^ (((ob >> 9) & 1) << 5)); }
__device__ __forceinline__ void stage_rc(int b, int& R, int& C) { const int st = b / 1024, sb = b % 1024, swz = sb ^ (((sb >> 9) & 1) << 5); R = (st >> 1) * 16 + swz / 64; C = (st & 1) * 32 + (swz % 64) / 2; }
__device__ __forceinline__ int perm32(int rho) { const int n = rho >> 4, i = rho & 15; return 8 * (i >> 2) + 4 * n + (i & 3); }

struct Unit { int pm, pn; };
struct Gemm { const bf16_t* A; const bf16_t* Bt; int M, N, K, lda; int split_pn; int split_off; };

struct StaticOrder {
    int nM, nN, nwg, G, c;
    __device__ void init(int M, int N, int G_, int c_) { nM = M / BM; nN = N / BM; nwg = nM * nN; G = G_; c = c_; }
    __device__ bool next(int i, Unit& u) const {
        const long L = (long)i * G + c; if (L >= nwg) return false;
        int wgid = (int)L; { const int q = nwg / NXCD, r = nwg % NXCD, xcd = wgid % NXCD, off = wgid / NXCD; wgid = (xcd < r ? xcd * (q + 1) : r * (q + 1) + (xcd - r) * q) + off; }
        const int nig = WGM * nN, gid = wgid / nig, fm = gid * WGM, gsz = (nM - fm) < WGM ? (nM - fm) : WGM;
        u.pm = fm + ((wgid % nig) % gsz); u.pn = (wgid % nig) / gsz; return true;
    }
};

template <class Epi>
__device__ __forceinline__ void gemm_phase(LAS unsigned char* lds, const Gemm g, const StaticOrder& S, const Epi& E) {
    int tid_ = threadIdx.x; asm volatile("" : "+v"(tid_));
    const int tid = tid_, wid = __builtin_amdgcn_readfirstlane(tid >> 6), lane = tid & 63, wr = wid >> 2, wc = wid & 3, fr = lane & 15, fq = lane >> 4;
    const int K = g.K, nt = K / BK, lda = g.lda;
    unsigned voffA[2], voffB[2];
#pragma unroll
    for (int i = 0; i < 2; ++i) { int R, C; stage_rc(tid * 16 + i * 8192, R, C); const int Rb = Epi::PERM ? ((R & ~31) + perm32(R & 31)) : R;
        voffA[i] = (unsigned)(R * lda + C) * 2u; voffB[i] = (unsigned)(Rb * K + C) * 2u; }
    const size_t kstep = (size_t)(BK * 2);
    const size_t hstepA = (size_t)HALF * lda * 2, hstepB = (size_t)HALF * K * 2;
    const size_t tstepA = 2 * hstepA, tstepB = 2 * hstepB;
    const unsigned ldsw = (unsigned)wid * 1024u;
    const int aoff = lds_byte(wr * 64 + fr, fq * 8), boff = lds_byte(wc * 32 + fr, fq * 8);
#define PG8_SA(b, h) (((b) * 2 + (h)) * HTB)
#define PG8_SB(b, h) ((4 + (b) * 2 + (h)) * HTB)
#define PG8_STAGE(bufoff, gbase, voff) do { _Pragma("unroll") for (int _i = 0; _i < 2; ++_i) \
        __builtin_amdgcn_global_load_lds((const unsigned*)((const char*)(gbase) + (voff)[_i]), (LAS unsigned*)(lds + (bufoff) + ldsw + _i * 8192), 16, 0, 0); } while (0)
#define PG8_LDA(dst, b, h) do { _Pragma("unroll") for (int m = 0; m < 4; ++m) _Pragma("unroll") for (int k = 0; k < 2; ++k) dst[m][k] = *(const LAS bf16x8*)(lds + PG8_SA(b, h) + aoff + m * 2048 + k * 1024); } while (0)
#define PG8_LDB(dst, b, h) do { _Pragma("unroll") for (int n = 0; n < 2; ++n) _Pragma("unroll") for (int k = 0; k < 2; ++k) dst[n][k] = *(const LAS bf16x8*)(lds + PG8_SB(b, h) + boff + n * 2048 + k * 1024); } while (0)
#define PG8_MMA(ai, bj, At, Bt) do { __builtin_amdgcn_s_setprio(1); _Pragma("unroll") for (int m = 0; m < 4; ++m) _Pragma("unroll") for (int n = 0; n < 2; ++n) _Pragma("unroll") for (int k = 0; k < 2; ++k) \
        acc[ai][bj][m][n] = __builtin_amdgcn_mfma_f32_16x16x32_bf16(Bt[n][k], At[m][k], acc[ai][bj][m][n], 0, 0, 0); __builtin_amdgcn_s_setprio(0); } while (0)
#define PG8_WAIT_V(n) asm volatile("s_waitcnt vmcnt(" #n ")" ::: "memory")
#define PG8_WAIT_L(n) asm volatile("s_waitcnt lgkmcnt(" #n ")" ::: "memory")
#define PG8_BAR __builtin_amdgcn_s_barrier()
#define PG8_SCHED __builtin_amdgcn_sched_barrier(0)
    Unit cur, nxt; int ui = 0;
    if (!S.next(0, cur)) return;
    f32x4 acc[2][2][4][2];
#pragma unroll
    for (int a = 0; a < 2; ++a)
#pragma unroll
        for (int b = 0; b < 2; ++b)
#pragma unroll
            for (int m = 0; m < 4; ++m)
#pragma unroll
                for (int n = 0; n < 2; ++n) acc[a][b][m][n] = (f32x4){0.f, 0.f, 0.f, 0.f};
    bf16x8 At[4][2], B0[2][2], B1[2][2];
    const char* cA = (const char*)g.A + (size_t)cur.pm * tstepA + (cur.pn >= g.split_pn ? g.split_off : 0); const char* cB = (const char*)g.Bt + (size_t)cur.pn * tstepB;
    PG8_STAGE(PG8_SB(0, 0), cB, voffB); PG8_STAGE(PG8_SA(0, 0), cA, voffA); PG8_STAGE(PG8_SB(0, 1), cB + hstepB, voffB); PG8_STAGE(PG8_SA(0, 1), cA + hstepA, voffA);
    if (wr == 1) PG8_BAR;
    PG8_WAIT_V(4); PG8_BAR;
    PG8_STAGE(PG8_SB(1, 0), cB + kstep, voffB); PG8_STAGE(PG8_SA(1, 0), cA + kstep, voffA); PG8_STAGE(PG8_SB(1, 1), cB + hstepB + kstep, voffB);
    PG8_WAIT_V(6); PG8_BAR;
    for (;;) {
        const bool has_next = S.next(ui + 1, nxt);
        const char* nA = has_next ? (const char*)g.A + (size_t)nxt.pm * tstepA + (nxt.pn >= g.split_pn ? g.split_off : 0) : cA; const char* nB = has_next ? (const char*)g.Bt + (size_t)nxt.pn * tstepB : cB;
        for (int t = 0; t < nt; t += 2) {
            const bool last = (t == nt - 2);
            const char* a1 = cA + (size_t)(t + 1) * kstep;
            const char* a2 = last ? nA : cA + (size_t)(t + 2) * kstep; const char* b2 = last ? nB : cB + (size_t)(t + 2) * kstep;
            const char* a3 = a2 + kstep; const char* b3 = b2 + kstep;
            PG8_LDB(B0, 0, 0); PG8_SCHED; PG8_LDA(At, 0, 0); PG8_STAGE(PG8_SA(1, 1), a1 + hstepA, voffA);
            PG8_WAIT_L(8); PG8_BAR; PG8_WAIT_L(0); PG8_MMA(0, 0, At, B0); PG8_BAR; PG8_SCHED;
            PG8_LDB(B1, 0, 1); PG8_STAGE(PG8_SB(0, 0), b2, voffB);
            PG8_BAR; PG8_WAIT_L(0); PG8_MMA(0, 1, At, B1); PG8_BAR;
            PG8_LDA(At, 0, 1); PG8_STAGE(PG8_SA(0, 0), a2, voffA);
            PG8_BAR; PG8_WAIT_L(0); PG8_MMA(1, 0, At, B0); PG8_BAR; PG8_SCHED;
            PG8_STAGE(PG8_SB(0, 1), b2 + hstepB, voffB);
            PG8_WAIT_V(6); PG8_BAR; PG8_MMA(1, 1, At, B1); PG8_BAR;
            PG8_LDB(B0, 1, 0); PG8_SCHED; PG8_LDA(At, 1, 0); PG8_STAGE(PG8_SA(0, 1), a2 + hstepA, voffA);
            PG8_WAIT_L(8); PG8_BAR; PG8_WAIT_L(0); PG8_MMA(0, 0, At, B0); PG8_BAR; PG8_SCHED;
            PG8_LDB(B1, 1, 1); PG8_STAGE(PG8_SB(1, 0), b3, voffB);
            PG8_BAR; PG8_WAIT_L(0); PG8_MMA(0, 1, At, B1); PG8_BAR;
            PG8_LDA(At, 1, 1); PG8_STAGE(PG8_SA(1, 0), a3, voffA);
            PG8_BAR; PG8_WAIT_L(0); PG8_MMA(1, 0, At, B0); PG8_BAR; PG8_SCHED;
            PG8_STAGE(PG8_SB(1, 1), b3 + hstepB, voffB);
            PG8_WAIT_V(6); PG8_BAR; PG8_MMA(1, 1, At, B1); PG8_BAR;
        }
        E(acc, cur, wr, wc, fr, fq);
        if (!has_next) break;
#pragma unroll
        for (int a = 0; a < 2; ++a)
#pragma unroll
            for (int b = 0; b < 2; ++b)
#pragma unroll
                for (int m = 0; m < 4; ++m)
#pragma unroll
                    for (int n = 0; n < 2; ++n) acc[a][b][m][n] = (f32x4){0.f, 0.f, 0.f, 0.f};
        cur = nxt; cA = nA; cB = nB; ++ui;
    }
    PG8_WAIT_V(0);
    if (wr == 0) PG8_BAR;
    PG8_BAR;
#undef PG8_SA
#undef PG8_SB
#undef PG8_STAGE
#undef PG8_LDA
#undef PG8_LDB
#undef PG8_MMA
#undef PG8_WAIT_V
#undef PG8_WAIT_L
#undef PG8_BAR
#undef PG8_SCHED
}
}

struct EpiP {
    static constexpr bool PERM = true;
    bf16_t* P; const float* rowsq;
    __device__ __forceinline__ void operator()(const f32x4 (&acc)[2][2][4][2], const pg8::Unit& u, int wr, int wc, int fr, int fq) const {
        const int row0 = u.pm * 256 + wr * 64 + fr, col0 = u.pn * 256 + wc * 32 + 8 * fq;
#pragma unroll
        for (int ai = 0; ai < 2; ++ai)
#pragma unroll
            for (int m = 0; m < 4; ++m) {
                const int row = row0 + ai * 128 + m * 16;
                const float rs = row_rs(rowsq, row);
                bf16_t* rowp = P + (size_t)row * DIN + col0;
#pragma unroll
                for (int bj = 0; bj < 2; ++bj) {
                    const f32x4 v0 = acc[ai][bj][m][0] * rs, v1 = acc[ai][bj][m][1] * rs;
                    u32x4 w; w.x = cvt_pk_bf16(v0[0], v0[1]); w.y = cvt_pk_bf16(v0[2], v0[3]); w.z = cvt_pk_bf16(v1[0], v1[1]); w.w = cvt_pk_bf16(v1[2], v1[3]);
                    *(u32x4*)(rowp + bj * 128) = w;
                }
            }
    }
};
struct EpiM {
    static constexpr bool PERM = true;
    bf16_t* P;
    __device__ __forceinline__ void operator()(const f32x4 (&acc)[2][2][4][2], const pg8::Unit& u, int wr, int wc, int fr, int fq) const {
        const int row0 = u.pm * 256 + wr * 64 + fr, col0 = u.pn * 256 + wc * 32 + 8 * fq;
#pragma unroll
        for (int ai = 0; ai < 2; ++ai)
#pragma unroll
            for (int m = 0; m < 4; ++m) {
                const int row = row0 + ai * 128 + m * 16;
                bf16_t* rowp = P + (size_t)row * DIN + col0;
#pragma unroll
                for (int bj = 0; bj < 2; ++bj) {
                    const u32x4 gw = *(const u32x4*)(rowp + 5120 + bj * 128);
                    float gf[8]; unpack8(gw, gf);
                    const f32x4 a0 = acc[ai][bj][m][0], a1 = acc[ai][bj][m][1];
                    float o[8];
#pragma unroll
                    for (int j = 0; j < 4; ++j) { o[j] = a0[j] * sigmoidf_(gf[j]); o[4 + j] = a1[j] * sigmoidf_(gf[4 + j]); }
                    *(u32x4*)(rowp + 3072 + bj * 128) = pack8(o);
                }
            }
    }
};
struct EpiRes {
    static constexpr bool PERM = false;
    float* X; bf16_t* XB; float* rowsq;
    __device__ __forceinline__ void operator()(const f32x4 (&acc)[2][2][4][2], const pg8::Unit& u, int wr, int wc, int fr, int fq) const {
        const int row0 = u.pm * 256 + wr * 64 + fr, col0 = u.pn * 256 + wc * 32 + 4 * fq;
#pragma unroll
        for (int ai = 0; ai < 2; ++ai)
#pragma unroll
            for (int m = 0; m < 4; ++m) {
                const int row = row0 + ai * 128 + m * 16;
                float* xr = X + (size_t)row * D + col0; bf16_t* xbr = XB + (size_t)row * D + col0;
                float ss = 0.f;
#pragma unroll
                for (int bj = 0; bj < 2; ++bj)
#pragma unroll
                    for (int n = 0; n < 2; ++n) {
                        f32x4 xv = *(const f32x4*)(xr + bj * 128 + n * 16);
                        xv += acc[ai][bj][m][n];
                        *(f32x4*)(xr + bj * 128 + n * 16) = xv;
                        ss += (xv[0] * xv[0] + xv[1] * xv[1]) + (xv[2] * xv[2] + xv[3] * xv[3]);
                        u32x2 w; w.x = cvt_pk_bf16(xv[0], xv[1]); w.y = cvt_pk_bf16(xv[2], xv[3]);
                        *(u32x2*)(xbr + bj * 128 + n * 16) = w;
                    }
                ss += __shfl_xor(ss, 16); ss += __shfl_xor(ss, 32);
                if (fq == 0) rowsq[(size_t)row * 16 + u.pn * 4 + wc] = ss;
            }
    }
};
struct EpiGlu {
    static constexpr bool PERM = false;
    bf16_t* P; const float* rowsq;
    __device__ __forceinline__ void operator()(const f32x4 (&acc)[2][2][4][2], const pg8::Unit& u, int wr, int wc, int fr, int fq) const {
        const int row0 = u.pm * 256 + wr * 64 + fr, col0 = u.pn * 128 + wc * 16 + 4 * fq;
#pragma unroll
        for (int ai = 0; ai < 2; ++ai)
#pragma unroll
            for (int m = 0; m < 4; ++m) {
                const int row = row0 + ai * 128 + m * 16;
                const float rs = row_rs(rowsq, row);
                bf16_t* rowp = P + (size_t)row * DIN + col0;
#pragma unroll
                for (int bj = 0; bj < 2; ++bj) {
                    const f32x4 gv = acc[ai][bj][m][0] * rs, uv = acc[ai][bj][m][1] * rs;
                    float o[4];
#pragma unroll
                    for (int j = 0; j < 4; ++j) o[j] = gv[j] * sigmoidf_(gv[j]) * uv[j];
                    u32x2 w; w.x = cvt_pk_bf16(o[0], o[1]); w.y = cvt_pk_bf16(o[2], o[3]);
                    *(u32x2*)(rowp + bj * 64) = w;
                }
            }
    }
};

__device__ __forceinline__ void cvt_tile(const float* src, int sld, const float* scale, bf16_t* dst, size_t dld, int n0, int mode, int rowoff, bf16_t* dst2,
                                         LAS bf16_t* T, int tid) {
#pragma unroll
    for (int i = 0; i < 2; ++i) {
        const int item = tid + NT * i, kr = item >> 4, nc = (item & 15) * 4;
        f32x4 v = *(const f32x4*)(src + (size_t)kr * sld + nc);
        const float s = scale ? scale[kr] : 1.0f;
        const unsigned w0 = cvt_pk_bf16(v[0] * s, v[1] * s), w1 = cvt_pk_bf16(v[2] * s, v[3] * s);
        T[(nc + 0) * 72 + kr] = (bf16_t)(w0 & 0xffff); T[(nc + 1) * 72 + kr] = (bf16_t)(w0 >> 16);
        T[(nc + 2) * 72 + kr] = (bf16_t)(w1 & 0xffff); T[(nc + 3) * 72 + kr] = (bf16_t)(w1 >> 16);
    }
    __syncthreads();
    {
        const int n = tid >> 3, kv = (tid & 7) * 8;
        const u32x4 w = *(const LAS u32x4*)(T + n * 72 + kv);
        const int ng = n0 + n;
        const int row = (mode == 0) ? (ng + rowoff) : ((ng >> 4) * 32 + (ng & 15) + (mode == 2 ? 16 : 0));
        *(u32x4*)(dst + (size_t)row * dld + kv) = w;
        if (dst2) *(u32x4*)(dst2 + (size_t)row * dld + kv) = w;
    }
    __syncthreads();
}

constexpr int CV_T0 = 16 * 112, CV_T1 = CV_T0 + 256, CV_T2 = CV_T1 + 256, CV_T3 = CV_T2 + 256, CV_T4 = CV_T3 + 16 * 44, CV_T5 = CV_T4 + 16 * 44, CV_T6 = CV_T5 + 44 * 16,
              CV_T7 = CV_T6 + 16, CV_T8 = CV_T7 + 16;
__device__ void convert_layer(const Params& p, int l, bf16_t* wset, LAS unsigned char* lds, int tid_in, int wg, int nwg) {
    int tid = tid_in; asm volatile("" : "+v"(tid));
    bf16_t* W1 = wset; bf16_t* WAB = W1 + W1_E; bf16_t* WO2 = WAB + WAB_E; bf16_t* WGU = WO2 + WO2_E; bf16_t* WD = WGU + WGU_E; bf16_t* WG = WD + WD_E;
    LAS bf16_t* T = (LAS bf16_t*)lds;
    for (int j = wg; j < CV_T8; j += nwg) {
        if (j < CV_T0) { const int kt = j / 112, ntl = j % 112;
            cvt_tile(p.in[7] + (size_t)l * D * DIN + (size_t)kt * 64 * DIN + ntl * 64, DIN, p.in[6] + l * D + kt * 64, W1 + kt * 64, D, ntl * 64, 0, 0, nullptr, T, tid);
        } else if (j < CV_T3) { const int which = (j - CV_T0) / 256, jj = (j - CV_T0) % 256, kt = jj / 16, ntl = jj % 16;
            if (which < 2) cvt_tile(p.in[which == 0 ? 15 : 17] + (size_t)l * D * D + (size_t)kt * 64 * D + ntl * 64, D, nullptr, WAB + kt * 64, D, ntl * 64, 0, which * 1024, nullptr, T, tid);
            else cvt_tile(p.in[18] + (size_t)l * D * D + (size_t)kt * 64 * D + ntl * 64, D, nullptr, WO2 + kt * 64, 2048, ntl * 64, 0, 0, WO2 + 1024 + kt * 64, T, tid);
        } else if (j < CV_T5) { const int which = (j - CV_T3) / 704, jj = (j - CV_T3) % 704, kt = jj / 44, ntl = jj % 44;
            cvt_tile(p.in[which == 0 ? 20 : 21] + (size_t)l * D * DFF + (size_t)kt * 64 * DFF + ntl * 64, DFF, p.in[19] + l * D + kt * 64, WGU + kt * 64, D, ntl * 64, 1 + which, 0, nullptr, T, tid);
        } else if (j < CV_T6) { const int jj = j - CV_T5, kt = jj / 16, ntl = jj % 16;
            cvt_tile(p.in[22] + (size_t)l * DFF * D + (size_t)kt * 64 * D + ntl * 64, D, nullptr, WD + kt * 64, DFF, ntl * 64, 0, 0, nullptr, T, tid);
        } else { const int which = (j - CV_T6) / 16, h = (j - CV_T6) % 16;
            cvt_tile(p.in[which == 0 ? 10 : 12] + (size_t)l * 16 * 4096 + (size_t)h * 4096, 64, nullptr, WG, 64, 0, 0, h * 128 + which * 64, nullptr, T, tid);
        }
    }
}

constexpr int XC_LD = 136;
constexpr int HB_LD = 132;
constexpr int N_MIX_TILES = 8 + 32 * NSEQ * 8 + 8 * 8;

__device__ __forceinline__ float gelu_tanh(float x) {
    const float t = 1.5957691216057308f * (x + 0.044715f * x * x * x);
    return x / (1.0f + __expf(-t));
}

__device__ void mixer_phase(const Params& p, int l, LAS unsigned char* lds, int tid_in, int wg, int nwg) {
    int tid = tid_in; asm volatile("" : "+v"(tid));
    bf16_t* P = (bf16_t*)(p.ws + OFF_P);
    const bf16_t* WG = (const bf16_t*)(p.ws + OFF_W + (size_t)(l & 1) * WSET_BYTES) + (W1_E + WAB_E + WO2_E + WGU_E + WD_E);
    u64* agg = (u64*)(p.ws + OFF_AGG) + (size_t)l * NSLOT * D;
    LAS bf16_t* XC = (LAS bf16_t*)lds;
    LAS float* HB = (LAS float*)(lds + 64 * XC_LD * 2);
    const float* w4 = p.in[8] + (size_t)l * 4 * D; const float* b4 = p.in[9] + (size_t)l * D;
    const float* w3 = p.in[16] + (size_t)l * 3 * D;
    const float* st_h = p.in[2] + (size_t)l * NDEC * D; const float* st_rc = p.in[3] + (size_t)l * NDEC * 3 * D; const float* st_sc = p.in[4] + (size_t)l * NDEC * 2 * D;
    float* out = p.out;
    const int wid = tid >> 6, lane = tid & 63, fr = lane & 15, fq = lane >> 4;

    for (int tile = wg; tile < N_MIX_TILES; tile += nwg) {
        int type, row0, hp, chunk = 0, seq = 0, ntok = 64;
        if (tile < 8) { type = 0; hp = tile; row0 = META_ROW0; ntok = 16; }
        else if (tile < 8 + 2048) { const int j = tile - 8; type = 1; hp = j & 7; seq = (j >> 3) & 7; chunk = j >> 6; row0 = seq * SEQ + chunk * 64; }
        else { const int j = tile - 8 - 2048; type = 2; hp = j & 7; chunk = j >> 3; row0 = SAMPLE_ROW0 + chunk * 64; }
        const int cbase = hp * 128;

#pragma unroll 1
        for (int i = 0; i < 2; ++i) {
            const int item = tid + NT * i, t = item >> 4, vec = item & 15, c = cbase + vec * 8;
            if (t >= ntok) { *(LAS u32x4*)(XC + t * XC_LD + vec * 8) = (u32x4){0u, 0u, 0u, 0u}; continue; }
            const int tt = t & 3, b = (type == 2) ? (chunk * 16 + (t >> 2)) : 0;
            float xc[8];
            { const f32x4 b0 = *(const f32x4*)(b4 + c), b1 = *(const f32x4*)(b4 + c + 4);
#pragma unroll
              for (int j = 0; j < 4; ++j) { xc[j] = b0[j]; xc[4 + j] = b1[j]; } }
            float xcur[8];
#pragma unroll
            for (int k = 0; k < 4; ++k) {
                float xv[8];
                const int d = (type == 2 ? tt : t) - 3 + k;
                bool zero = false; int prow = row0 + t - 3 + k; bool from_state = false;
                if (d < 0) {
                    if (type == 0) zero = true;
                    else if (type == 1) { if (chunk == 0) prow = META_ROW0 + NMETA + d; }
                    else from_state = true;
                }
                if (zero) {
#pragma unroll
                    for (int j = 0; j < 8; ++j) xv[j] = 0.f;
                } else if (from_state) {
                    const float* sp = st_rc + ((size_t)b * 3 + (d + 3)) * D + c;
                    const f32x4 s0 = *(const f32x4*)sp, s1 = *(const f32x4*)(sp + 4);
#pragma unroll
                    for (int j = 0; j < 4; ++j) { xv[j] = s0[j]; xv[4 + j] = s1[j]; }
                } else {
                    unpack8(*(const u32x4*)(P + (size_t)prow * DIN + c), xv);
                }
                const f32x4 wa = *(const f32x4*)(w4 + k * D + c), wb = *(const f32x4*)(w4 + k * D + c + 4);
#pragma unroll
                for (int j = 0; j < 4; ++j) { xc[j] += wa[j] * xv[j]; xc[4 + j] += wb[j] * xv[4 + j]; }
                if (k == 3) {
#pragma unroll
                    for (int j = 0; j < 8; ++j) xcur[j] = xv[j];
                }
            }
            *(LAS u32x4*)(XC + t * XC_LD + vec * 8) = pack8(xc);
            float vacc[8], prodcur[8];
#pragma unroll
            for (int j = 0; j < 8; ++j) vacc[j] = 0.f;
#pragma unroll
            for (int k = 0; k < 3; ++k) {
                float pv[8];
                const int d = (type == 2 ? tt : t) - 2 + k;
                bool zero = false; int prow = row0 + t - 2 + k; bool from_state = false;
                if (d < 0) {
                    if (type == 0) zero = true;
                    else if (type == 1) { if (chunk == 0) prow = META_ROW0 + NMETA + d; }
                    else from_state = true;
                }
                if (zero) {
#pragma unroll
                    for (int j = 0; j < 8; ++j) pv[j] = 0.f;
                } else if (from_state) {
                    const float* sp = st_sc + ((size_t)b * 2 + (d + 2)) * D + c;
                    const f32x4 s0 = *(const f32x4*)sp, s1 = *(const f32x4*)(sp + 4);
#pragma unroll
                    for (int j = 0; j < 4; ++j) { pv[j] = s0[j]; pv[4 + j] = s1[j]; }
                } else {
                    float cv[8], hv[8];
                    unpack8(*(const u32x4*)(P + (size_t)prow * DIN + 3072 + c), cv);
                    unpack8(*(const u32x4*)(P + (size_t)prow * DIN + 4096 + c), hv);
#pragma unroll
                    for (int j = 0; j < 8; ++j) pv[j] = cv[j] * hv[j];
                }
                const f32x4 wa = *(const f32x4*)(w3 + k * D + c), wb = *(const f32x4*)(w3 + k * D + c + 4);
#pragma unroll
                for (int j = 0; j < 4; ++j) { vacc[j] += wa[j] * pv[j]; vacc[4 + j] += wb[j] * pv[4 + j]; }
                if (k == 2) {
#pragma unroll
                    for (int j = 0; j < 8; ++j) prodcur[j] = pv[j];
                }
            }
            {
                bf16_t* bp = P + (size_t)(row0 + t) * DIN + 2048 + c;
                float bv[8]; unpack8(*(const u32x4*)bp, bv);
#pragma unroll
                for (int j = 0; j < 8; ++j) bv[j] *= vacc[j];
                *(u32x4*)bp = pack8(bv);
            }
            if (type == 1 && chunk == 31) {
                if (t >= 61) { float* o = out + O_RCP + (((size_t)l * NSEQ + seq) * 3 + (t - 61)) * D + c;
                    *(f32x4*)o = (f32x4){xcur[0], xcur[1], xcur[2], xcur[3]}; *(f32x4*)(o + 4) = (f32x4){xcur[4], xcur[5], xcur[6], xcur[7]}; }
                if (t >= 62) { float* o = out + O_SCP + (((size_t)l * NSEQ + seq) * 2 + (t - 62)) * D + c;
                    *(f32x4*)o = (f32x4){prodcur[0], prodcur[1], prodcur[2], prodcur[3]}; *(f32x4*)(o + 4) = (f32x4){prodcur[4], prodcur[5], prodcur[6], prodcur[7]}; }
            } else if (type == 2) {
                if (tt >= 1) { float* o = out + O_RCS + (((size_t)l * NDEC + b) * 3 + (tt - 1)) * D + c;
                    *(f32x4*)o = (f32x4){xcur[0], xcur[1], xcur[2], xcur[3]}; *(f32x4*)(o + 4) = (f32x4){xcur[4], xcur[5], xcur[6], xcur[7]}; }
                if (tt >= 2) { float* o = out + O_SCS + (((size_t)l * NDEC + b) * 2 + (tt - 2)) * D + c;
                    *(f32x4*)o = (f32x4){prodcur[0], prodcur[1], prodcur[2], prodcur[3]}; *(f32x4*)(o + 4) = (f32x4){prodcur[4], prodcur[5], prodcur[6], prodcur[7]}; }
            }
        }
        __syncthreads();

        {
            const int hl = wid >> 2, cgi = wid & 3;
            const int head = hp * 2 + hl;
            const int chl = wid * 16 + fr;
            const int C = cbase + chl;
            bf16x8 Bf[2][2];
#pragma unroll
            for (int g = 0; g < 2; ++g)
#pragma unroll
                for (int ks = 0; ks < 2; ++ks) Bf[g][ks] = *(const bf16x8*)(WG + ((size_t)(head * 128 + g * 64 + cgi * 16 + fr)) * 64 + ks * 32 + fq * 8);
            const float bav = p.in[11][l * D + C], bxv = p.in[13][l * D + C];
            const float spv = log1pf(__expf(-p.in[14][l * D + C]));
            const int nmt = (type == 0) ? 1 : 4;
            float Pl[4][4], Hl[4][4];
            float cP = 1.f, cH = 0.f;
#pragma unroll
            for (int mt = 0; mt < 4; ++mt) {
                if (mt < nmt) {
                    f32x4 ar = (f32x4){0.f, 0.f, 0.f, 0.f}, ai = (f32x4){0.f, 0.f, 0.f, 0.f};
#pragma unroll
                    for (int ks = 0; ks < 2; ++ks) {
                        const bf16x8 Af = *(const LAS bf16x8*)(XC + (mt * 16 + fr) * XC_LD + hl * 64 + ks * 32 + fq * 8);
                        ar = __builtin_amdgcn_mfma_f32_16x16x32_bf16(Af, Bf[0][ks], ar, 0, 0, 0);
                        ai = __builtin_amdgcn_mfma_f32_16x16x32_bf16(Af, Bf[1][ks], ai, 0, 0, 0);
                    }
                    float av[4], uv[4];
#pragma unroll
                    for (int r = 0; r < 4; ++r) {
                        const float rg = sigmoidf_(ar[r] + bav), ig = sigmoidf_(ai[r] + bxv);
                        const float la = -8.0f * rg * spv;
                        const float x2 = 2.0f * la;
                        const float em = (x2 > -0.05f) ? -x2 * (1.0f + x2 * (0.5f + x2 * (0.16666667f + x2 * 0.041666667f))) : 1.0f - __expf(x2);
                        av[r] = __expf(la);
                        const float xcv = bf2f(XC[(mt * 16 + fq * 4 + r) * XC_LD + chl]);
                        uv[r] = sqrtf(fmaxf(em, 1e-12f)) * ig * xcv;
                    }
                    if (type == 2) {
                        const int b = chunk * 16 + mt * 4 + fq;
                        float h = st_h[(size_t)b * D + C];
#pragma unroll
                        for (int r = 0; r < 4; ++r) { h = av[r] * h + uv[r]; Hl[mt][r] = h; Pl[mt][r] = 0.f; }
                        out[O_HS + ((size_t)l * NDEC + b) * D + C] = h;
                    } else {
                        float pp[4], hh[4];
                        pp[0] = av[0]; hh[0] = uv[0];
#pragma unroll
                        for (int r = 1; r < 4; ++r) { pp[r] = pp[r - 1] * av[r]; hh[r] = av[r] * hh[r - 1] + uv[r]; }
                        float ap = pp[3], ah = hh[3];
                        float tp = __shfl_up(ap, 16), th = __shfl_up(ah, 16);
                        if (fq >= 1) { ah = ap * th + ah; ap = ap * tp; }
                        tp = __shfl_up(ap, 32); th = __shfl_up(ah, 32);
                        if (fq >= 2) { ah = ap * th + ah; ap = ap * tp; }
                        float ep = __shfl_up(ap, 16), eh = __shfl_up(ah, 16);
                        if (fq == 0) { ep = 1.f; eh = 0.f; }
                        const float bp = cP * ep, bh = ep * cH + eh;
#pragma unroll
                        for (int r = 0; r < 4; ++r) { Pl[mt][r] = bp * pp[r]; Hl[mt][r] = pp[r] * bh + hh[r]; }
                        tp = __shfl(ap, 48 + fr); th = __shfl(ah, 48 + fr);
                        cH = tp * cH + th; cP = cP * tp;
                    }
                } else {
#pragma unroll
                    for (int r = 0; r < 4; ++r) { Pl[mt][r] = 0.f; Hl[mt][r] = 0.f; }
                }
            }
            if (type != 2) {
                const int slot = (type == 0) ? 0 : (1 + seq * 32 + chunk);
                if (fq == 0) __hip_atomic_store(agg + (size_t)slot * D + C, ((u64)__float_as_uint(cH) << 32) | (u64)__float_as_uint(cP), __ATOMIC_RELAXED, __HIP_MEMORY_SCOPE_AGENT);
                float carry = 0.f;
                if (type == 1) {
                    const int npred = chunk + 1, cnt = (npred + 3) >> 2, jb = fq * cnt;
                    u64 v[8];
                    unsigned spins = 0;
                    for (;;) {
                        bool ok = true;
#pragma unroll
                        for (int i = 0; i < 8; ++i) {
                            const int j = jb + i;
                            if (i < cnt && j < npred) {
                                const int sl = (j == 0) ? 0 : (seq * 32 + j);
                                v[i] = __hip_atomic_load(agg + (size_t)sl * D + C, __ATOMIC_RELAXED, __HIP_MEMORY_SCOPE_AGENT);
                                ok = ok && ((unsigned)v[i] != 0xFFFFFFFFu);
                            } else v[i] = 0ull;
                        }
                        if (__all(ok)) break;
                        if (++spins > 200000u) break;
                        __builtin_amdgcn_s_sleep(2);
                    }
                    float Ag = 1.f, Hg = 0.f;
#pragma unroll
                    for (int i = 0; i < 8; ++i) {
                        const int j = jb + i;
                        if (i < cnt && j < npred) { const float A = __uint_as_float((unsigned)v[i]), H = __uint_as_float((unsigned)(v[i] >> 32)); Hg = A * Hg + H; Ag = A * Ag; }
                    }
#pragma unroll
                    for (int q = 0; q < 4; ++q) { const float Aq = __shfl(Ag, q * 16 + fr), Hq = __shfl(Hg, q * 16 + fr); carry = Aq * carry + Hq; }
                }
#pragma unroll
                for (int mt = 0; mt < 4; ++mt)
#pragma unroll
                    for (int r = 0; r < 4; ++r) Hl[mt][r] = Hl[mt][r] + Pl[mt][r] * carry;
                if (type == 1 && chunk == 31 && fq == 3) out[O_HP + ((size_t)l * NSEQ + seq) * D + C] = Hl[3][3];
            }
#pragma unroll
            for (int mt = 0; mt < 4; ++mt)
#pragma unroll
                for (int r = 0; r < 4; ++r) HB[(mt * 16 + fq * 4 + r) * HB_LD + chl] = Hl[mt][r];
        }
        __syncthreads();

#pragma unroll 1
        for (int i = 0; i < 2; ++i) {
            const int item = tid + NT * i, t = item >> 4, vec = item & 15, c = cbase + vec * 8;
            if (t >= ntok) continue;
            bf16_t* gp = P + (size_t)(row0 + t) * DIN + 1024 + c;
            float gv[8]; unpack8(*(const u32x4*)gp, gv);
            const f32x4 h0 = *(const LAS f32x4*)(HB + t * HB_LD + vec * 8), h1 = *(const LAS f32x4*)(HB + t * HB_LD + vec * 8 + 4);
            float o[8];
#pragma unroll
            for (int j = 0; j < 4; ++j) { o[j] = h0[j] * gelu_tanh(gv[j]); o[4 + j] = h1[j] * gelu_tanh(gv[4 + j]); }
            *(u32x4*)gp = pack8(o);
        }
    }
    __syncthreads();
}

__global__ void __launch_bounds__(NT, 2) fwd_megakernel(Params p) {
    extern __shared__ __attribute__((aligned(16))) unsigned char lds_raw[];
    LAS unsigned char* lds = (LAS unsigned char*)lds_raw;
    cg::grid_group grid = cg::this_grid();
    const int tid = threadIdx.x, wg = blockIdx.x, nwg = gridDim.x;
    const int wid = tid >> 6, lane = tid & 63;
    unsigned char* ws = p.ws;
    bf16_t* P = (bf16_t*)(ws + OFF_P);
    float* X = (float*)(ws + OFF_X);
    bf16_t* XB = (bf16_t*)(ws + OFF_XB);
    float* RS1 = (float*)(ws + OFF_RS1);
    float* RS2 = (float*)(ws + OFF_RS2);

#ifndef NO_CVT
    convert_layer(p, 0, (bf16_t*)(ws + OFF_W), lds, tid, wg, nwg);
#endif
    for (int row = wg * 8 + wid; row < MPAD; row += nwg * 8) {
        const float* src = nullptr;
        if (row < SAMPLE_ROW0) src = p.in[0] + (size_t)row * D;
        else if (row < META_ROW0) src = p.in[1] + (size_t)(row - SAMPLE_ROW0) * D;
        else if (row < META_ROW0 + NMETA) src = p.in[5] + (size_t)(row - META_ROW0) * D;
        float ss = 0.f;
#pragma unroll
        for (int i = 0; i < 4; ++i) {
            const int c = i * 256 + lane * 4;
            f32x4 v = (f32x4){0.f, 0.f, 0.f, 0.f};
            if (src) v = *(const f32x4*)(src + c);
            *(f32x4*)(X + (size_t)row * D + c) = v;
            u32x2 w; w.x = cvt_pk_bf16(v[0], v[1]); w.y = cvt_pk_bf16(v[2], v[3]);
            *(u32x2*)(XB + (size_t)row * D + c) = w;
            ss += (v[0] * v[0] + v[1] * v[1]) + (v[2] * v[2] + v[3] * v[3]);
        }
#pragma unroll
        for (int o = 32; o >= 1; o >>= 1) ss += __shfl_xor(ss, o);
        if (lane < 16) RS1[(size_t)row * 16 + lane] = (lane == 0) ? ss : 0.f;
    }
    {
        u32x4* a = (u32x4*)(ws + OFF_AGG);
        const size_t n16 = AGG_BYTES / 16;
        for (size_t i = (size_t)wg * NT + tid; i < n16; i += (size_t)nwg * NT) a[i] = (u32x4){0xFFFFFFFFu, 0xFFFFFFFFu, 0xFFFFFFFFu, 0xFFFFFFFFu};
    }
    grid.sync();

    for (int l = 0; l < DEPTH; ++l) {
        const bf16_t* wset = (const bf16_t*)(ws + OFF_W + (size_t)(l & 1) * WSET_BYTES);
        const bf16_t* W1 = wset; const bf16_t* WAB = W1 + W1_E; const bf16_t* WO2 = WAB + WAB_E; const bf16_t* WGU = WO2 + WO2_E; const bf16_t* WD = WGU + WGU_E;
        {
            pg8::Gemm g{XB, W1, MPAD, DIN, D, D, 1 << 30, 0}; pg8::StaticOrder S; S.init(MPAD, DIN, nwg, wg);
            EpiP E{P, RS1};
#if !defined(ONLY) || ONLY==1
            pg8::gemm_phase<EpiP>(lds, g, S, E);
#endif
        }
        grid.sync();
#ifndef NO_CVT
        if (l + 1 < DEPTH) convert_layer(p, l + 1, (bf16_t*)(ws + OFF_W + (size_t)((l + 1) & 1) * WSET_BYTES), lds, tid, wg, nwg);
#endif
#ifndef NO_MIXER
        mixer_phase(p, l, lds, tid, wg, nwg);
#endif
        grid.sync();
        {
            pg8::Gemm g{P + 1024, WAB, MPAD, 2048, D, DIN, 4, 1024 * 2}; pg8::StaticOrder S; S.init(MPAD, 2048, nwg, wg);
            EpiM E{P};
#if !defined(ONLY) || ONLY==2
            pg8::gemm_phase<EpiM>(lds, g, S, E);
#endif
        }
        grid.sync();
        {
            pg8::Gemm g{P + 3072, WO2, MPAD, D, 2048, DIN, 1 << 30, 0}; pg8::StaticOrder S; S.init(MPAD, D, nwg, wg);
            EpiRes E{X, XB, RS2};
#if !defined(ONLY) || ONLY==3
            pg8::gemm_phase<EpiRes>(lds, g, S, E);
#endif
        }
        grid.sync();
        {
            pg8::Gemm g{XB, WGU, MPAD, 2 * DFF, D, D, 1 << 30, 0}; pg8::StaticOrder S; S.init(MPAD, 2 * DFF, nwg, wg);
            EpiGlu E{P, RS2};
#if !defined(ONLY) || ONLY==4
            pg8::gemm_phase<EpiGlu>(lds, g, S, E);
#endif
        }
        grid.sync();
        {
            pg8::Gemm g{P, WD, MPAD, D, DFF, DIN, 1 << 30, 0}; pg8::StaticOrder S; S.init(MPAD, D, nwg, wg);
            EpiRes E{X, XB, RS1};
#if !defined(ONLY) || ONLY==5
            pg8::gemm_phase<EpiRes>(lds, g, S, E);
#endif
        }
        grid.sync();
    }

    {
        const float* gfin = p.in[23];
        for (int row = wg * 8 + wid; row < MOUT; row += nwg * 8) {
            const float rs = row_rs(RS1, row);
#pragma unroll
            for (int i = 0; i < 4; ++i) {
                const int c = i * 256 + lane * 4;
                const f32x4 v = *(const f32x4*)(X + (size_t)row * D + c), gg = *(const f32x4*)(gfin + c);
                *(f32x4*)(p.out + O_Y + (size_t)row * D + c) = v * rs * gg;
            }
        }
    }
}

extern "C" void kernel_launch(void* const* d_in, const int* in_sizes, int n_in, void* d_out, int out_size, void* d_ws, size_t ws_size, hipStream_t stream) {
    static int gridn = 0;
    if (!gridn) {
        int dev = 0, cus = 0, per_cu = 0;
        (void)hipGetDevice(&dev);
        (void)hipDeviceGetAttribute(&cus, hipDeviceAttributeMultiprocessorCount, dev);
        (void)hipFuncSetAttribute((const void*)fwd_megakernel, hipFuncAttributeMaxDynamicSharedMemorySize, LDS_BYTES);
        (void)hipOccupancyMaxActiveBlocksPerMultiprocessor(&per_cu, (const void*)fwd_megakernel, NT, LDS_BYTES);
        if (per_cu < 1) { fprintf(stderr, "kernel_launch: occupancy query says %d blocks per CU\n", per_cu); per_cu = 1; }
        gridn = cus;
        if (ws_size < WS_NEED) fprintf(stderr, "kernel_launch: workspace too small: %zu < %zu\n", ws_size, (size_t)WS_NEED);
    }
    if (ws_size < WS_NEED || n_in != 24) return;
    Params p{};
    for (int i = 0; i < 24; ++i) p.in[i] = (const float*)d_in[i];
    p.out = (float*)d_out; p.ws = (unsigned char*)d_ws;
    void* args[] = {&p};
    hipError_t e = hipLaunchCooperativeKernel((const void*)fwd_megakernel, dim3(gridn), dim3(NT), args, LDS_BYTES, stream);
    if (e != hipSuccess) fprintf(stderr, "kernel_launch: cooperative launch failed: %s (grid %d)\n", hipGetErrorString(e), gridn);
}
```

```cpp
#include <hip/hip_runtime.h>
#include <hip/hip_cooperative_groups.h>
#include <cstdio>
namespace cg = cooperative_groups;

#define LAS __attribute__((address_space(3)))
typedef unsigned short bf16_t;
typedef short bf16x8 __attribute__((ext_vector_type(8)));
typedef float f32x4 __attribute__((ext_vector_type(4)));
typedef unsigned u32x4 __attribute__((ext_vector_type(4)));
typedef unsigned u32x2 __attribute__((ext_vector_type(2)));
typedef unsigned long long u64;

constexpr int D = 1024, DIN = 7168, DFF = 2816, DEPTH = 4;
constexpr int NSEQ = 8, SEQ = 2048, NDEC = 128, DECT = 4, NMETA = 16;
constexpr int SAMPLE_ROW0 = NSEQ * SEQ;
constexpr int META_ROW0 = SAMPLE_ROW0 + NDEC * DECT;
constexpr int MOUT = META_ROW0;
constexpr int MPAD = 17152;
constexpr float EPS = 1e-6f;
constexpr int NT = 512;
constexpr int LDS_BYTES = 128 * 1024 + 16;

constexpr size_t P_BYTES = (size_t)MPAD * DIN * 2;
constexpr size_t X_BYTES = (size_t)MPAD * D * 4;
constexpr size_t XB_BYTES = (size_t)MPAD * D * 2;
constexpr size_t W1_E = (size_t)DIN * D, WAB_E = (size_t)2048 * D, WO2_E = (size_t)D * 2048, WGU_E = (size_t)2 * DFF * D, WD_E = (size_t)D * DFF, WG_E = (size_t)16 * 128 * 64;
constexpr size_t WSET_E = W1_E + WAB_E + WO2_E + WGU_E + WD_E + WG_E;
constexpr size_t WSET_BYTES = WSET_E * 2;
constexpr int NSLOT = 1 + NSEQ * 32;
constexpr size_t AGG_BYTES = (size_t)DEPTH * NSLOT * D * 8;
constexpr size_t OFF_P = 0, OFF_X = OFF_P + P_BYTES, OFF_XB = OFF_X + X_BYTES, OFF_W = OFF_XB + XB_BYTES, OFF_RS1 = OFF_W + 2 * WSET_BYTES,
                 OFF_RS2 = OFF_RS1 + (size_t)MPAD * 128, OFF_AGG = OFF_RS2 + (size_t)MPAD * 128, OFF_BAR = OFF_AGG + AGG_BYTES, WS_NEED = OFF_BAR + 16384;

constexpr size_t O_Y = 0, O_HP = (size_t)MOUT * D, O_RCP = O_HP + (size_t)DEPTH * NSEQ * D, O_SCP = O_RCP + (size_t)DEPTH * NSEQ * 3 * D,
                 O_HS = O_SCP + (size_t)DEPTH * NSEQ * 2 * D, O_RCS = O_HS + (size_t)DEPTH * NDEC * D, O_SCS = O_RCS + (size_t)DEPTH * NDEC * 3 * D;

struct Params {
    const float* in[24];
    float* out;
    unsigned char* ws;
};

__device__ __forceinline__ const float* in_ptr(int i) {
    const __attribute__((address_space(4))) char* ka = (const __attribute__((address_space(4))) char*)__builtin_amdgcn_kernarg_segment_ptr();
    return *(const float* const volatile __attribute__((address_space(4)))*)(ka + 8 * i);
}

__device__ __forceinline__ unsigned cvt_pk_bf16(float lo, float hi) { unsigned r; asm volatile("v_cvt_pk_bf16_f32 %0, %1, %2" : "=v"(r) : "v"(lo), "v"(hi)); return r; }
__device__ __forceinline__ float bf_lo(unsigned w) { return __uint_as_float(w << 16); }
__device__ __forceinline__ float bf_hi(unsigned w) { return __uint_as_float(w & 0xffff0000u); }
__device__ __forceinline__ float bf2f(bf16_t b) { return __uint_as_float(((unsigned)b) << 16); }
__device__ __forceinline__ float sigmoidf_(float x) { return __builtin_amdgcn_rcpf(1.0f + __builtin_amdgcn_exp2f(-1.4426950408889634f * x)); }
__device__ __forceinline__ void unpack8(const u32x4 w, float (&f)[8]) {
    f[0] = bf_lo(w.x); f[1] = bf_hi(w.x); f[2] = bf_lo(w.y); f[3] = bf_hi(w.y); f[4] = bf_lo(w.z); f[5] = bf_hi(w.z); f[6] = bf_lo(w.w); f[7] = bf_hi(w.w);
}
__device__ __forceinline__ u32x4 pack8(const float (&f)[8]) {
    u32x4 w; w.x = cvt_pk_bf16(f[0], f[1]); w.y = cvt_pk_bf16(f[2], f[3]); w.z = cvt_pk_bf16(f[4], f[5]); w.w = cvt_pk_bf16(f[6], f[7]); return w;
}

__device__ __forceinline__ float row_rs(const float* rsp, int row) {
    const f32x4* q = (const f32x4*)(rsp + (size_t)row * 32);
    const f32x4 s = ((q[0] + q[1]) + (q[2] + q[3])) + ((q[4] + q[5]) + (q[6] + q[7]));
    return rsqrtf(((s[0] + s[1]) + (s[2] + s[3])) * (1.0f / D) + EPS);
}

__device__ __forceinline__ float row_rs4(const float* rsp, int row, int fq) {
    const f32x4* q = (const f32x4*)(rsp + (size_t)row * 32) + 2 * fq;
    const f32x4 s = q[0] + q[1];
    float t = (s[0] + s[1]) + (s[2] + s[3]);
    t += __shfl_xor(t, 16); t += __shfl_xor(t, 32);
    return rsqrtf(t * (1.0f / D) + EPS);
}

namespace pg8 {
constexpr int BM = 256, BK = 64, HALF = 128, HTB = HALF * BK * 2, STAGE_BYTES = 8 * HTB, NXCD = 8, WGM = 8;
__device__ __forceinline__ int lds_byte(int r, int c) { const int st = (r >> 4) * 2 + (c >> 5), rr = r & 15, cc = c & 31, ob = rr * 64 + cc * 2; return st * 1024 + (ob ^ (((ob >> 9) & 1) << 5)); }
__device__ __forceinline__ void stage_rc(int b, int& R, int& C) { const int st = b / 1024, sb = b % 1024, swz = sb ^ (((sb >> 9) & 1) << 5); R = (st >> 1) * 16 + swz / 64; C = (st & 1) * 32 + (swz % 64) / 2; }
__device__ __forceinline__ int perm32(int rho) { const int n = rho >> 4, i = rho & 15; return 8 * (i >> 2) + 4 * n + (i & 3); }

struct Unit { int pm, pn; };
struct Gemm { const bf16_t* A; const bf16_t* Bt; int M, N, K, lda; int split_pn; int split_off; };

struct StaticOrder {
    int nM, nN, nwg, G, c;
    __device__ void init(int M, int N, int G_, int c_) { nM = M / BM; nN = N / BM; nwg = nM * nN; G = G_; c = c_; }
    __device__ bool next(int i, Unit& u) const {
        const long L = (long)i * G + c; if (L >= nwg) return false;
        int wgid = (int)L; { const int q = nwg / NXCD, r = nwg % NXCD, xcd = wgid % NXCD, off = wgid / NXCD; wgid = (xcd < r ? xcd * (q + 1) : r * (q + 1) + (xcd - r) * q) + off; }
        const int nig = WGM * nN, gid = wgid / nig, fm = gid * WGM, gsz = (nM - fm) < WGM ? (nM - fm) : WGM;
        u.pm = fm + ((wgid % nig) % gsz); u.pn = (wgid % nig) / gsz; return true;
    }
};

template <class Epi>
__device__ __forceinline__ unsigned long long gemm_phase(LAS unsigned char* lds, const Gemm g, const StaticOrder& S, const Epi& E) {
    unsigned long long epi_ticks = 0;
    int tid_ = threadIdx.x; asm volatile("" : "+v"(tid_));
    const int tid = tid_, wid = __builtin_amdgcn_readfirstlane(tid >> 6), lane = tid & 63, wr = wid >> 2, wc = wid & 3, fr = lane & 15, fq = lane >> 4;
    const int K = g.K, nt = K / BK, lda = g.lda;
    unsigned voffA[2], voffB[2];
#pragma unroll
    for (int i = 0; i < 2; ++i) { int R, C; stage_rc(tid * 16 + i * 8192, R, C); voffA[i] = (unsigned)(R * lda + C) * 2u; voffB[i] = (unsigned)(R * K + C) * 2u; }
    const size_t kstep = (size_t)(BK * 2);
    const size_t hstepA = (size_t)HALF * lda * 2, hstepB = (size_t)HALF * K * 2;
    const size_t tstepA = 2 * hstepA, tstepB = 2 * hstepB;
    const unsigned ldsw = (unsigned)wid * 1024u;
    const int aoff = lds_byte(wr * 64 + fr, fq * 8), boff = lds_byte(wc * 32 + fr, fq * 8);
#define PG8_SA(b, h) (((b) * 2 + (h)) * HTB)
#define PG8_SB(b, h) ((4 + (b) * 2 + (h)) * HTB)
#define PG8_STAGE(bufoff, gbase, voff) do { _Pragma("unroll") for (int _i = 0; _i < 2; ++_i) \
        __builtin_amdgcn_global_load_lds((const unsigned*)((const char*)(gbase) + (voff)[_i]), (LAS unsigned*)(lds + (bufoff) + ldsw + _i * 8192), 16, 0, 0); } while (0)
#define PG8_LDA(dst, b, h) do { _Pragma("unroll") for (int m = 0; m < 4; ++m) _Pragma("unroll") for (int k = 0; k < 2; ++k) dst[m][k] = *(const LAS bf16x8*)(lds + PG8_SA(b, h) + aoff + m * 2048 + k * 1024); } while (0)
#define PG8_LDB(dst, b, h) do { _Pragma("unroll") for (int n = 0; n < 2; ++n) _Pragma("unroll") for (int k = 0; k < 2; ++k) dst[n][k] = *(const LAS bf16x8*)(lds + PG8_SB(b, h) + boff + n * 2048 + k * 1024); } while (0)
#define PG8_MMA(ai, bj, At, Bt) do { __builtin_amdgcn_s_setprio(1); _Pragma("unroll") for (int m = 0; m < 4; ++m) _Pragma("unroll") for (int n = 0; n < 2; ++n) _Pragma("unroll") for (int k = 0; k < 2; ++k) \
        acc[ai][bj][m][n] = __builtin_amdgcn_mfma_f32_16x16x32_bf16(Bt[n][k], At[m][k], acc[ai][bj][m][n], 0, 0, 0); __builtin_amdgcn_s_setprio(0); } while (0)
#define PG8_WAIT_V(n) asm volatile("s_waitcnt vmcnt(" #n ")" ::: "memory")
#define PG8_WAIT_L(n) asm volatile("s_waitcnt lgkmcnt(" #n ")" ::: "memory")
#define PG8_BAR __builtin_amdgcn_s_barrier()
#define PG8_SCHED __builtin_amdgcn_sched_barrier(0)
    Unit cur, nxt; int ui = 0;
    if (!S.next(0, cur)) return 0;
    f32x4 acc[2][2][4][2];
#pragma unroll
    for (int a = 0; a < 2; ++a)
#pragma unroll
        for (int b = 0; b < 2; ++b)
#pragma unroll
            for (int m = 0; m < 4; ++m)
#pragma unroll
                for (int n = 0; n < 2; ++n) acc[a][b][m][n] = (f32x4){0.f, 0.f, 0.f, 0.f};
    bf16x8 At[4][2], B0[2][2], B1[2][2];
    const char* cA = (const char*)g.A + (size_t)cur.pm * tstepA + (cur.pn >= g.split_pn ? g.split_off : 0); const char* cB = (const char*)g.Bt + (size_t)cur.pn * tstepB;
    PG8_STAGE(PG8_SB(0, 0), cB, voffB); PG8_STAGE(PG8_SA(0, 0), cA, voffA); PG8_STAGE(PG8_SB(0, 1), cB + hstepB, voffB); PG8_STAGE(PG8_SA(0, 1), cA + hstepA, voffA);
    if (wr == 1) PG8_BAR;
    PG8_WAIT_V(4); PG8_BAR;
    PG8_STAGE(PG8_SB(1, 0), cB + kstep, voffB); PG8_STAGE(PG8_SA(1, 0), cA + kstep, voffA); PG8_STAGE(PG8_SB(1, 1), cB + hstepB + kstep, voffB);
    PG8_WAIT_V(6); PG8_BAR;
    for (;;) {
        const bool has_next = S.next(ui + 1, nxt);
        const char* nA = has_next ? (const char*)g.A + (size_t)nxt.pm * tstepA + (nxt.pn >= g.split_pn ? g.split_off : 0) : cA; const char* nB = has_next ? (const char*)g.Bt + (size_t)nxt.pn * tstepB : cB;
#define PG8_KTRIP(t) do { \
            const bool last = (t == nt - 2); \
            const char* a1 = cA + (size_t)(t + 1) * kstep; \
            const char* a2 = last ? nA : cA + (size_t)(t + 2) * kstep; const char* b2 = last ? nB : cB + (size_t)(t + 2) * kstep; \
            const char* a3 = a2 + kstep; const char* b3 = b2 + kstep; \
            PG8_LDB(B0, 0, 0); PG8_SCHED; PG8_LDA(At, 0, 0); PG8_STAGE(PG8_SA(1, 1), a1 + hstepA, voffA); \
            PG8_WAIT_L(8); PG8_BAR; PG8_WAIT_L(0); PG8_MMA(0, 0, At, B0); PG8_BAR; PG8_SCHED; \
            PG8_LDB(B1, 0, 1); PG8_STAGE(PG8_SB(0, 0), b2, voffB); \
            PG8_BAR; PG8_WAIT_L(0); PG8_MMA(0, 1, At, B1); PG8_BAR; \
            PG8_LDA(At, 0, 1); PG8_STAGE(PG8_SA(0, 0), a2, voffA); \
            PG8_BAR; PG8_WAIT_L(0); PG8_MMA(1, 0, At, B0); PG8_BAR; PG8_SCHED; \
            PG8_STAGE(PG8_SB(0, 1), b2 + hstepB, voffB); \
            PG8_WAIT_V(6); PG8_BAR; PG8_MMA(1, 1, At, B1); PG8_BAR; \
            PG8_LDB(B0, 1, 0); PG8_SCHED; PG8_LDA(At, 1, 0); PG8_STAGE(PG8_SA(0, 1), a2 + hstepA, voffA); \
            PG8_WAIT_L(8); PG8_BAR; PG8_WAIT_L(0); PG8_MMA(0, 0, At, B0); PG8_BAR; PG8_SCHED; \
            PG8_LDB(B1, 1, 1); PG8_STAGE(PG8_SB(1, 0), b3, voffB); \
            PG8_BAR; PG8_WAIT_L(0); PG8_MMA(0, 1, At, B1); PG8_BAR; \
            PG8_LDA(At, 1, 1); PG8_STAGE(PG8_SA(1, 0), a3, voffA); \
            PG8_BAR; PG8_WAIT_L(0); PG8_MMA(1, 0, At, B0); PG8_BAR; PG8_SCHED; \
            PG8_STAGE(PG8_SB(1, 1), b3 + hstepB, voffB); \
            PG8_WAIT_V(6); PG8_BAR; PG8_MMA(1, 1, At, B1); PG8_BAR; \
        } while (0)
        if constexpr (Epi::MIDK) {
            for (int t = 0; t < (nt >> 1); t += 2) PG8_KTRIP(t);
            E.mid(acc, cur, wr, wc, fr, fq);
            for (int t = (nt >> 1); t < nt; t += 2) PG8_KTRIP(t);
        } else {
            for (int t = 0; t < nt; t += 2) PG8_KTRIP(t);
        }
#undef PG8_KTRIP
#ifdef PROBE_MODE
        const unsigned long long te0 = __builtin_amdgcn_s_memrealtime();
#endif
        E(acc, cur, wr, wc, fr, fq);
#ifdef PROBE_MODE
        asm volatile("s_waitcnt vmcnt(0)" ::: "memory"); epi_ticks += __builtin_amdgcn_s_memrealtime() - te0;
#endif
        if (!has_next) break;
#pragma unroll
        for (int a = 0; a < 2; ++a)
#pragma unroll
            for (int b = 0; b < 2; ++b)
#pragma unroll
                for (int m = 0; m < 4; ++m)
#pragma unroll
                    for (int n = 0; n < 2; ++n) acc[a][b][m][n] = (f32x4){0.f, 0.f, 0.f, 0.f};
        cur = nxt; cA = nA; cB = nB; ++ui;
    }
    PG8_WAIT_V(0);
    if (wr == 0) PG8_BAR;
    PG8_BAR;
    return epi_ticks;
#undef PG8_SA
#undef PG8_SB
#undef PG8_STAGE
#undef PG8_LDA
#undef PG8_LDB
#undef PG8_MMA
#undef PG8_WAIT_V
#undef PG8_WAIT_L
#undef PG8_BAR
#undef PG8_SCHED
}
}

struct EpiP {
    static constexpr bool MIDK = false;
    static constexpr bool PERM = true;
    bf16_t* P; const float* rowsq;
    __device__ __forceinline__ void operator()(const f32x4 (&acc)[2][2][4][2], const pg8::Unit& u, int wr, int wc, int fr, int fq) const {
        const int row0 = u.pm * 256 + wr * 64 + fr, col0 = u.pn * 256 + wc * 32 + 8 * fq;
        if (u.pn >= 12 && u.pn < 20) {
            bf16_t* pp = P + (size_t)row0 * DIN + 3072 + (u.pn - 12) * 128 + wc * 32 + 8 * fq;
#pragma unroll
            for (int ai = 0; ai < 2; ++ai)
#pragma unroll
                for (int m = 0; m < 4; ++m) {
                    const float rs = row_rs4(rowsq, row0 + ai * 128 + m * 16, fq), rs2 = rs * rs;
                    const f32x4 q0 = acc[ai][0][m][0] * acc[ai][0][m][1] * rs2, q1 = acc[ai][1][m][0] * acc[ai][1][m][1] * rs2;
                    u32x4 w; w.x = cvt_pk_bf16(q0[0], q0[1]); w.y = cvt_pk_bf16(q0[2], q0[3]); w.z = cvt_pk_bf16(q1[0], q1[1]); w.w = cvt_pk_bf16(q1[2], q1[3]);
                    *(u32x4*)(pp + (size_t)(ai * 128 + m * 16) * DIN) = w;
                }
            return;
        }
#pragma unroll
        for (int ai = 0; ai < 2; ++ai) {
            f32x4 q0[4], q1[4];
#pragma unroll
            for (int m = 0; m < 4; ++m) { const f32x4* q = (const f32x4*)(rowsq + (size_t)(row0 + ai * 128 + m * 16) * 32) + 2 * fq; q0[m] = q[0]; q1[m] = q[1]; }
            __builtin_amdgcn_sched_barrier(0);
#pragma unroll
            for (int m = 0; m < 4; ++m) {
                const int row = row0 + ai * 128 + m * 16;
                const f32x4 sv = q0[m] + q1[m];
                float t = (sv[0] + sv[1]) + (sv[2] + sv[3]);
                t += __shfl_xor(t, 16); t += __shfl_xor(t, 32);
                const float rs = rsqrtf(t * (1.0f / D) + EPS);
                bf16_t* rowp = P + (size_t)row * DIN + col0;
#pragma unroll
                for (int bj = 0; bj < 2; ++bj) {
                    const f32x4 v0 = acc[ai][bj][m][0] * rs, v1 = acc[ai][bj][m][1] * rs;
                    u32x4 w; w.x = cvt_pk_bf16(v0[0], v0[1]); w.y = cvt_pk_bf16(v0[2], v0[3]); w.z = cvt_pk_bf16(v1[0], v1[1]); w.w = cvt_pk_bf16(v1[2], v1[3]);
                    *(u32x4*)(rowp + bj * 128) = w;
                }
            }
        }
    }
};
struct EpiM {
    static constexpr bool PERM = true, MIDK = true;
    bf16_t* P;
    __device__ __forceinline__ void mid(f32x4 (&acc)[2][2][4][2], const pg8::Unit& u, int wr, int wc, int fr, int fq) const {
        const int row0 = u.pm * 256 + wr * 64 + fr, col0 = u.pn * 256 + wc * 32 + 8 * fq;
        const bf16_t* gbase = P + (size_t)row0 * DIN + col0 + 5120;
#pragma unroll
        for (int ai = 0; ai < 2; ++ai)
#pragma unroll
            for (int mp = 0; mp < 2; ++mp) {
                u32x4 ga[2][2], gb[2][2];
#pragma unroll
                for (int mm = 0; mm < 2; ++mm) { const bf16_t* gp = gbase + (size_t)(ai * 128 + (mp * 2 + mm) * 16) * DIN;
#pragma unroll
                    for (int bj = 0; bj < 2; ++bj) { ga[mm][bj] = *(const u32x4*)(gp + bj * 128); gb[mm][bj] = *(const u32x4*)(gp + 1024 + bj * 128); } }
                __builtin_amdgcn_sched_barrier(0);
#pragma unroll
                for (int mm = 0; mm < 2; ++mm) {
                    const int m = mp * 2 + mm;
#pragma unroll
                    for (int bj = 0; bj < 2; ++bj) {
                        float fa[8], fb[8]; unpack8(ga[mm][bj], fa); unpack8(gb[mm][bj], fb);
                        f32x4 r0, r1;
#pragma unroll
                        for (int j = 0; j < 4; ++j) {
                            r0[j] = (1.0f + __builtin_amdgcn_exp2f(-1.4426950408889634f * fb[j])) * __builtin_amdgcn_rcpf(1.0f + __builtin_amdgcn_exp2f(-1.4426950408889634f * fa[j]));
                            r1[j] = (1.0f + __builtin_amdgcn_exp2f(-1.4426950408889634f * fb[4 + j])) * __builtin_amdgcn_rcpf(1.0f + __builtin_amdgcn_exp2f(-1.4426950408889634f * fa[4 + j]));
                        }
                        acc[ai][bj][m][0] *= r0; acc[ai][bj][m][1] *= r1;
                    }
                }
            }
    }
    __device__ __forceinline__ void operator()(const f32x4 (&acc)[2][2][4][2], const pg8::Unit& u, int wr, int wc, int fr, int fq) const {
        const int row0 = u.pm * 256 + wr * 64 + fr, col0 = u.pn * 256 + wc * 32 + 8 * fq;
#pragma unroll
        for (int ai = 0; ai < 2; ++ai)
#pragma unroll
            for (int mp = 0; mp < 2; ++mp) {
                u32x4 gw[2][2];
#pragma unroll
                for (int mm = 0; mm < 2; ++mm)
#pragma unroll
                    for (int bj = 0; bj < 2; ++bj) gw[mm][bj] = *(const u32x4*)(P + (size_t)(row0 + ai * 128 + (mp * 2 + mm) * 16) * DIN + col0 + 6144 + bj * 128);
                __builtin_amdgcn_sched_barrier(0);
#pragma unroll
                for (int mm = 0; mm < 2; ++mm) {
                    const int m = mp * 2 + mm;
                    const int row = row0 + ai * 128 + m * 16;
                    bf16_t* rowp = P + (size_t)row * DIN + col0;
#pragma unroll
                    for (int bj = 0; bj < 2; ++bj) {
                        float gf[8]; unpack8(gw[mm][bj], gf);
                        const f32x4 a0 = acc[ai][bj][m][0], a1 = acc[ai][bj][m][1];
                        float o[8];
#pragma unroll
                        for (int j = 0; j < 4; ++j) { o[j] = a0[j] * sigmoidf_(gf[j]); o[4 + j] = a1[j] * sigmoidf_(gf[4 + j]); }
                        *(u32x4*)(rowp + 3072 + bj * 128) = pack8(o);
                    }
                }
            }
    }
};
struct EpiRes {
    static constexpr bool MIDK = false;
    static constexpr bool PERM = true;
    float* X; bf16_t* XB; float* rowsq;
    __device__ __forceinline__ void operator()(const f32x4 (&acc)[2][2][4][2], const pg8::Unit& u, int wr, int wc, int fr, int fq) const {
        const int row0 = u.pm * 256 + wr * 64 + fr, col0 = u.pn * 256 + wc * 32 + 8 * fq;
#pragma unroll
        for (int ai = 0; ai < 2; ++ai)
#pragma unroll
            for (int mp = 0; mp < 2; ++mp) {
                u32x4 xv[2][2];
#pragma unroll
                for (int mm = 0; mm < 2; ++mm)
#pragma unroll
                    for (int bj = 0; bj < 2; ++bj) xv[mm][bj] = *(const u32x4*)(XB + (size_t)(row0 + ai * 128 + (mp * 2 + mm) * 16) * D + col0 + bj * 128);
                __builtin_amdgcn_sched_barrier(0);
#pragma unroll
                for (int mm = 0; mm < 2; ++mm) {
                    const int m = mp * 2 + mm;
                    const int row = row0 + ai * 128 + m * 16;
                    bf16_t* xbr = XB + (size_t)row * D + col0;
#pragma unroll
                    for (int bj = 0; bj < 2; ++bj) {
                        float xf[8]; unpack8(xv[mm][bj], xf);
                        float o[8]; float ss = 0.f;
#pragma unroll
                        for (int jj = 0; jj < 4; ++jj) { o[jj] = xf[jj] + acc[ai][bj][m][0][jj]; o[4 + jj] = xf[4 + jj] + acc[ai][bj][m][1][jj]; }
#pragma unroll
                        for (int jj = 0; jj < 8; ++jj) ss += o[jj] * o[jj];
                        *(u32x4*)(xbr + bj * 128) = pack8(o);
                        ss += __shfl_xor(ss, 16); ss += __shfl_xor(ss, 32);
                        if (fq == 0) rowsq[(size_t)row * 32 + u.pn * 8 + bj * 4 + wc] = ss;
                    }
                }
            }
    }
};
struct EpiGlu {
    static constexpr bool MIDK = false;
    static constexpr bool PERM = false;
    bf16_t* P; const float* rowsq;
    __device__ __forceinline__ void operator()(const f32x4 (&acc)[2][2][4][2], const pg8::Unit& u, int wr, int wc, int fr, int fq) const {
        const int row0 = u.pm * 256 + wr * 64 + fr, col0 = u.pn * 128 + wc * 16 + 4 * fq;
#pragma unroll
        for (int aih = 0; aih < 4; ++aih) {
            const int ai = aih >> 1;
            f32x4 q0[4], q1[4];
#pragma unroll
            for (int m = 0; m < 4; ++m) if ((m >> 1) == (aih & 1)) { const f32x4* q = (const f32x4*)(rowsq + (size_t)(row0 + ai * 128 + m * 16) * 32) + 2 * fq; q0[m] = q[0]; q1[m] = q[1]; }
            __builtin_amdgcn_sched_barrier(0);
#pragma unroll
            for (int m = 0; m < 4; ++m) if ((m >> 1) == (aih & 1)) {
                const int row = row0 + ai * 128 + m * 16;
                const f32x4 sv = q0[m] + q1[m];
                float t = (sv[0] + sv[1]) + (sv[2] + sv[3]);
                t += __shfl_xor(t, 16); t += __shfl_xor(t, 32);
                const float rs = rsqrtf(t * (1.0f / D) + EPS);
                bf16_t* rowp = P + (size_t)row * DIN + col0;
#pragma unroll
                for (int bj = 0; bj < 2; ++bj) {
                    const f32x4 gv = acc[ai][bj][m][0] * rs, uv = acc[ai][bj][m][1] * rs;
                    float o[4];
#pragma unroll
                    for (int j = 0; j < 4; ++j) o[j] = gv[j] * sigmoidf_(gv[j]) * uv[j];
                    u32x2 w; w.x = cvt_pk_bf16(o[0], o[1]); w.y = cvt_pk_bf16(o[2], o[3]);
                    *(u32x2*)(rowp + bj * 64) = w;
                }
            }
        }
    }
};

constexpr int XROW0 = SAMPLE_ROW0, XRB = 5, XTILES_M = 7;
struct MiniM {
    static constexpr bool AB = true;
    bf16_t* P;
    __device__ __forceinline__ void operator()(const f32x4 (&fa)[2], const f32x4 (&fb)[2], int row, int ct, int fq) const {
        bf16_t* rowp = P + (size_t)row * DIN + ct * 32 + 8 * fq;
        float ga[8], gb[8]; unpack8(*(const u32x4*)(rowp + 5120), ga); unpack8(*(const u32x4*)(rowp + 6144), gb);
        float o[8];
#pragma unroll
        for (int j = 0; j < 4; ++j) { o[j] = fa[0][j] * sigmoidf_(ga[j]) + fb[0][j] * sigmoidf_(gb[j]); o[4 + j] = fa[1][j] * sigmoidf_(ga[4 + j]) + fb[1][j] * sigmoidf_(gb[4 + j]); }
        *(u32x4*)(rowp + 3072) = pack8(o);
    }
};
struct MiniRes {
    static constexpr bool AB = false;
    float* X; bf16_t* XB; float* rowsq;
    __device__ __forceinline__ void operator()(const f32x4 (&acc)[2], const f32x4 (&)[2], int row, int ct, int fq) const {
        bf16_t* xbr = XB + (size_t)row * D + ct * 32 + 8 * fq;
        float xf[8]; unpack8(*(const u32x4*)xbr, xf);
        float o[8]; float ss = 0.f;
#pragma unroll
        for (int jj = 0; jj < 4; ++jj) { o[jj] = xf[jj] + acc[0][jj]; o[4 + jj] = xf[4 + jj] + acc[1][jj]; }
#pragma unroll
        for (int jj = 0; jj < 8; ++jj) ss += o[jj] * o[jj];
        *(u32x4*)xbr = pack8(o);
        ss += __shfl_xor(ss, 16); ss += __shfl_xor(ss, 32);
        if (fq == 0) rowsq[(size_t)row * 32 + ct] = ss;
    }
};
template <class Epi>
__device__ __forceinline__ void mini_phase(LAS unsigned char* lds, const bf16_t* A, int lda, int a_split_ct, int a_split_off, const bf16_t* Bt, int K, int nct, const Epi& E, int tid_in, int wg, int nwg) {
    int tid = tid_in; asm volatile("" : "+v"(tid));
    const int wid = __builtin_amdgcn_readfirstlane(tid >> 6), lane = tid & 63, fr = lane & 15, fq = lane >> 4;
    LAS f32x4* R = (LAS f32x4*)lds;
    const int kslice = K >> 3, nks = kslice >> 5;
    for (int tile = wg; tile < XTILES_M * nct; tile += nwg) {
        const int ct = tile / XTILES_M, rt = tile % XTILES_M;
        const int row0 = XROW0 + rt * (16 * XRB);
        const bf16_t* ap = A + (size_t)(row0 + fr) * lda + (ct >= a_split_ct ? a_split_off : 0) + wid * kslice + fq * 8;
        const bf16_t* bp = Bt + (size_t)(ct * 32 + fr) * K + wid * kslice + fq * 8;
        f32x4 acc[XRB][2];
#pragma unroll
        for (int rb = 0; rb < XRB; ++rb) { acc[rb][0] = (f32x4){0.f, 0.f, 0.f, 0.f}; acc[rb][1] = (f32x4){0.f, 0.f, 0.f, 0.f}; }
        bf16x8 a0[XRB], b0[2], a1[XRB], b1[2];
#define MINI_LOAD(a, b, ks) do { _Pragma("unroll") for (int rb = 0; rb < XRB; ++rb) a[rb] = *(const bf16x8*)(ap + (size_t)rb * 16 * lda + (ks) * 32); \
            b[0] = *(const bf16x8*)(bp + (ks) * 32); b[1] = *(const bf16x8*)(bp + (size_t)16 * K + (ks) * 32); } while (0)
#define MINI_MMA(a, b) do { _Pragma("unroll") for (int rb = 0; rb < XRB; ++rb) { \
            acc[rb][0] = __builtin_amdgcn_mfma_f32_16x16x32_bf16(b[0], a[rb], acc[rb][0], 0, 0, 0); \
            acc[rb][1] = __builtin_amdgcn_mfma_f32_16x16x32_bf16(b[1], a[rb], acc[rb][1], 0, 0, 0); } } while (0)
        MINI_LOAD(a0, b0, 0);
        for (int ks = 0; ks < nks; ks += 2) {
            if (ks + 1 < nks) MINI_LOAD(a1, b1, ks + 1);
            __builtin_amdgcn_sched_barrier(0);
            MINI_MMA(a0, b0);
            __builtin_amdgcn_sched_barrier(0);
            if (ks + 2 < nks) MINI_LOAD(a0, b0, ks + 2);
            __builtin_amdgcn_sched_barrier(0);
            if (ks + 1 < nks) MINI_MMA(a1, b1);
            __builtin_amdgcn_sched_barrier(0);
        }
#undef MINI_LOAD
#undef MINI_MMA
#pragma unroll
        for (int rb = 0; rb < XRB; ++rb) { R[((wid * XRB + rb) * 2 + 0) * 64 + lane] = acc[rb][0]; R[((wid * XRB + rb) * 2 + 1) * 64 + lane] = acc[rb][1]; }
        __syncthreads();
        if (wid < XRB) {
            f32x4 fin[2], finb[2];
            fin[0] = R[((0 * XRB + wid) * 2 + 0) * 64 + lane]; fin[1] = R[((0 * XRB + wid) * 2 + 1) * 64 + lane];
            finb[0] = R[((4 * XRB + wid) * 2 + 0) * 64 + lane]; finb[1] = R[((4 * XRB + wid) * 2 + 1) * 64 + lane];
#pragma unroll
            for (int w2 = 1; w2 < 4; ++w2) { fin[0] += R[((w2 * XRB + wid) * 2 + 0) * 64 + lane]; fin[1] += R[((w2 * XRB + wid) * 2 + 1) * 64 + lane];
                                             finb[0] += R[(((w2 + 4) * XRB + wid) * 2 + 0) * 64 + lane]; finb[1] += R[(((w2 + 4) * XRB + wid) * 2 + 1) * 64 + lane]; }
            if (!Epi::AB) { fin[0] += finb[0]; fin[1] += finb[1]; }
            E(fin, finb, row0 + wid * 16 + fr, ct, fq);
        }
        __syncthreads();
    }
}

template <int NB>
__device__ __forceinline__ void cvt_tile(const float* src, int sld, const float* scale, bf16_t* dst, size_t dld, int n0, int mode, int rowoff, bf16_t* dst2,
                                         LAS bf16_t* Tb, int tid) {
    constexpr int NC = 64 * NB, LD = NC + 4, SH = (NB == 4) ? 6 : 4, CM = (NB == 4) ? 63 : 15, NI = 2 * NB;
    LAS float* T = (LAS float*)Tb;
    f32x4 v[NI];
#pragma unroll
    for (int i = 0; i < NI; ++i) { const int item = tid + NT * i, kr = item >> SH, nc = (item & CM) * 4; v[i] = *(const f32x4*)(src + (size_t)kr * sld + nc); }
#pragma unroll
    for (int i = 0; i < NI; ++i) {
        const int item = tid + NT * i, kr = item >> SH, nc = (item & CM) * 4;
        const float s = scale ? scale[kr] : 1.0f;
        *(LAS f32x4*)(T + kr * LD + nc) = v[i] * s;
    }
    __syncthreads();
#pragma unroll
    for (int i = 0; i < NB; ++i) {
        const int item = tid + NT * i, n = item % NC, kc = item / NC;
        float f[8];
#pragma unroll
        for (int j = 0; j < 8; ++j) f[j] = T[(kc * 8 + j) * LD + n];
        const u32x4 w = pack8(f);
        const int ng = n0 + n;
        const int c32 = ng & 31;
        const int qch = ng - ((mode == 5) ? 4096 : 3072);
        const int row = (mode == 0) ? (ng + rowoff) : (mode == 3) ? ((ng & ~31) + 16 * ((c32 >> 2) & 1) + 4 * (c32 >> 3) + (c32 & 3) + rowoff)
                      : (mode >= 4) ? (3072 + 256 * (qch >> 7) + 128 * ((qch >> 2) & 1) + 32 * ((qch >> 5) & 3) + (mode == 5 ? 16 : 0) + 4 * ((qch >> 3) & 3) + (qch & 3))
                                                                 : ((ng >> 4) * 32 + (ng & 15) + (mode == 2 ? 16 : 0));
        *(u32x4*)(dst + (size_t)row * dld + kc * 8) = w;
        if (dst2) *(u32x4*)(dst2 + (size_t)row * dld + kc * 8) = w;
    }
    __syncthreads();
}

constexpr int CV_T0 = 16 * 28, CV_T1 = CV_T0 + 64, CV_T2 = CV_T1 + 64, CV_T3 = CV_T2 + 64, CV_T4 = CV_T3 + 16 * 11, CV_T5 = CV_T4 + 16 * 11, CV_T6 = CV_T5 + 44 * 4,
              CV_T7 = CV_T6 + 16, CV_T8 = CV_T7 + 16, CV_SPLIT = 880;
__device__ __forceinline__ void convert_layer(const Params& p, int l, bf16_t* wset, LAS unsigned char* lds, int tid_in, int wg, int nwg, int j0, int j1) {
    int tid = tid_in; asm volatile("" : "+v"(tid));
    bf16_t* W1 = wset; bf16_t* WAB = W1 + W1_E; bf16_t* WO2 = WAB + WAB_E; bf16_t* WGU = WO2 + WO2_E; bf16_t* WD = WGU + WGU_E; bf16_t* WG = WD + WD_E;
    LAS bf16_t* T = (LAS bf16_t*)lds;
    for (int j = j0 + wg; j < j1; j += nwg) {
        if (j < CV_T0) { const int kt = j / 28, ntl = j % 28;
            cvt_tile<4>(in_ptr(7) + (size_t)l * D * DIN + (size_t)kt * 64 * DIN + ntl * 256, DIN, in_ptr(6) + l * D + kt * 64, W1 + kt * 64, D, ntl * 256, (ntl >= 12 && ntl < 16) ? 4 : (ntl >= 16 && ntl < 20) ? 5 : 3, 0, nullptr, T, tid);
        } else if (j < CV_T3) { const int which = (j - CV_T0) / 64, jj = (j - CV_T0) % 64, kt = jj / 4, ntl = jj % 4;
            if (which < 2) cvt_tile<4>(in_ptr(which == 0 ? 15 : 17) + (size_t)l * D * D + (size_t)kt * 64 * D + ntl * 256, D, nullptr, WAB + which * 1024 + kt * 64, 2048, ntl * 256, 3, 0, nullptr, T, tid);
            else cvt_tile<4>(in_ptr(18) + (size_t)l * D * D + (size_t)kt * 64 * D + ntl * 256, D, nullptr, WO2 + kt * 64, D, ntl * 256, 3, 0, nullptr, T, tid);
        } else if (j < CV_T5) { const int which = (j - CV_T3) / 176, jj = (j - CV_T3) % 176, kt = jj / 11, ntl = jj % 11;
            cvt_tile<4>(in_ptr(which == 0 ? 20 : 21) + (size_t)l * D * DFF + (size_t)kt * 64 * DFF + ntl * 256, DFF, in_ptr(19) + l * D + kt * 64, WGU + kt * 64, D, ntl * 256, 1 + which, 0, nullptr, T, tid);
        } else if (j < CV_T6) { const int jj = j - CV_T5, kt = jj / 4, ntl = jj % 4;
            cvt_tile<4>(in_ptr(22) + (size_t)l * DFF * D + (size_t)kt * 64 * D + ntl * 256, D, nullptr, WD + kt * 64, DFF, ntl * 256, 3, 0, nullptr, T, tid);
        } else { const int which = (j - CV_T6) / 16, h = (j - CV_T6) % 16;
            cvt_tile<1>(in_ptr(which == 0 ? 10 : 12) + (size_t)l * 16 * 4096 + (size_t)h * 4096, 64, nullptr, WG, 64, 0, 0, h * 128 + which * 64, nullptr, T, tid);
        }
    }
}

constexpr int XC_LD = 136;
constexpr int HB_LD = 132;
constexpr int N_MIX_TILES = 8 + 32 * NSEQ * 8 + 8 * 8;

__device__ __forceinline__ float gelu_tanh(float x) {
    const float t = -2.3022082f * (x + 0.044715f * x * x * x);
    return x * __builtin_amdgcn_rcpf(1.0f + __builtin_amdgcn_exp2f(t));
}

__device__ __forceinline__ void mixer_phase(const Params& p, int l, LAS unsigned char* lds, int tid_in, int wg, int nwg) {
    int tid = tid_in; asm volatile("" : "+v"(tid));
    bf16_t* P = (bf16_t*)(p.ws + OFF_P);
    const bf16_t* WG = (const bf16_t*)(p.ws + OFF_W + (size_t)(l & 1) * WSET_BYTES) + (W1_E + WAB_E + WO2_E + WGU_E + WD_E);
    u64* agg = (u64*)(p.ws + OFF_AGG) + (size_t)l * NSLOT * D;
    LAS bf16_t* XC = (LAS bf16_t*)lds;
    LAS float* HB = (LAS float*)(lds + 64 * XC_LD * 2);
    const float* w4 = in_ptr(8) + (size_t)l * 4 * D; const float* b4 = in_ptr(9) + (size_t)l * D;
    const float* w3 = in_ptr(16) + (size_t)l * 3 * D;
    const float* st_h = in_ptr(2) + (size_t)l * NDEC * D; const float* st_rc = in_ptr(3) + (size_t)l * NDEC * 3 * D; const float* st_sc = in_ptr(4) + (size_t)l * NDEC * 2 * D;
    float* out = p.out;
    const int wid = tid >> 6, lane = tid & 63, fr = lane & 15, fq = lane >> 4;

    const bool hp_fixed = (nwg & 7) == 0;
    const int hp0 = wg & 7;
    LAS float* CW = (LAS float*)(lds + 64 * XC_LD * 2 + 64 * HB_LD * 4);
    const int hl = wid >> 2, cgi = wid & 3;
    const int chl = wid * 16 + fr;
    LAS bf16_t* GWL = (LAS bf16_t*)(lds + 64 * XC_LD * 2 + 64 * HB_LD * 4 + 8 * 128 * 4);
    LAS u32x4* GRL = (LAS u32x4*)(lds + 64 * XC_LD * 2 + 64 * HB_LD * 4 + 8 * 128 * 4 + 256 * 72 * 2);
    float bav = 0.f, bxv = 0.f, spv = 0.f;
#define LOAD_HEAD_CONSTS(hp_) do { \
        const int cb_ = (hp_) * 128, C_ = cb_ + chl; \
        bav = in_ptr(11)[l * D + C_]; bxv = in_ptr(13)[l * D + C_]; spv = log1pf(__expf(-in_ptr(14)[l * D + C_])); \
        for (int i_ = tid; i_ < 8 * 128; i_ += NT) { const int a_ = i_ >> 7, ch_ = i_ & 127; \
            CW[i_] = (a_ < 4) ? w4[a_ * D + cb_ + ch_] : (a_ == 4) ? b4[cb_ + ch_] : w3[(a_ - 5) * D + cb_ + ch_]; } \
        for (int i_ = tid; i_ < 256 * 8; i_ += NT) { const int r_ = i_ >> 3, kc_ = (i_ & 7) * 8; \
            *(LAS u32x4*)(GWL + r_ * 72 + kc_) = *(const u32x4*)(WG + ((size_t)((hp_) * 256 + r_)) * 64 + kc_); } \
        __syncthreads(); } while (0)
    if (hp_fixed) LOAD_HEAD_CONSTS(hp0);
#define MIX_DECODE(tile_, type_, row0_, hp_, chunk_, seq_, ntok_) do { chunk_ = 0; seq_ = 0; ntok_ = 64; \
        if ((tile_) < 8) { type_ = 0; hp_ = (tile_); row0_ = META_ROW0; ntok_ = 16; } \
        else if ((tile_) < 8 + 2048) { const int j_ = (tile_) - 8; type_ = 1; hp_ = j_ & 7; seq_ = (j_ >> 3) & 7; chunk_ = j_ >> 6; row0_ = seq_ * SEQ + chunk_ * 64; } \
        else { const int j_ = (tile_) - 8 - 2048; type_ = 2; hp_ = j_ & 7; chunk_ = j_ >> 3; row0_ = SAMPLE_ROW0 + chunk_ * 64; } } while (0)
    u32x4 xr_[5], pr_[4], bc_[2];
    int n_type = 0, n_row0 = 0, n_hp = 0, n_chunk = 0, n_seq = 0, n_ntok = 0;
    if (wg < N_MIX_TILES) {
        MIX_DECODE(wg, n_type, n_row0, n_hp, n_chunk, n_seq, n_ntok);
        const int type = n_type, row0 = n_row0, chunk = n_chunk, ntok = n_ntok, cbase = n_hp * 128;
        const int vec = tid & 15, t0 = tid >> 4, c = cbase + vec * 8;
            {
                const int tb = 2 * t0; const bool valid = tb < ntok;
#pragma unroll
                for (int j = 0; j < 5; ++j) {
                    const int d = ((type == 2) ? (tb & 3) : tb) - 3 + j;
                    int row = row0 + tb - 3 + j;
                    if (d < 0) row = (type == 0) ? (MPAD - 1) : ((chunk > 0) ? row : (META_ROW0 + NMETA + d));
                    if (!valid) row = MPAD - 1;
                    if (type == 2 && d < 0) {
                        const int b = chunk * 16 + (tb >> 2);
                        const float* sp = st_rc + ((size_t)b * 3 + (d + 3)) * D + c;
                        const f32x4 s0 = *(const f32x4*)sp, s1 = *(const f32x4*)(sp + 4);
                        xr_[j] = (u32x4){cvt_pk_bf16(s0[0], s0[1]), cvt_pk_bf16(s0[2], s0[3]), cvt_pk_bf16(s1[0], s1[1]), cvt_pk_bf16(s1[2], s1[3])};
                        if (j >= 1) {
                            const float* sq = st_sc + ((size_t)b * 2 + (d + 2)) * D + c;
                            const f32x4 q0 = *(const f32x4*)sq, q1 = *(const f32x4*)(sq + 4);
                            pr_[j - 1] = (u32x4){cvt_pk_bf16(q0[0], q0[1]), cvt_pk_bf16(q0[2], q0[3]), cvt_pk_bf16(q1[0], q1[1]), cvt_pk_bf16(q1[2], q1[3])};
                        }
                    } else {
                        const bf16_t* rp = P + (size_t)row * DIN + c;
                        xr_[j] = *(const u32x4*)rp;
                        if (j >= 1) pr_[j - 1] = *(const u32x4*)(rp + 3072);
                        if (j >= 3) bc_[j - 3] = *(const u32x4*)(rp + 2048);
                    }
                }
            }
    }
    for (int tile = wg; tile < N_MIX_TILES; tile += nwg) {
        const int type = n_type, row0 = n_row0, hp = n_hp, chunk = n_chunk, seq = n_seq, ntok = n_ntok;
        const int cbase = hp * 128;
        if (!hp_fixed) { __syncthreads(); LOAD_HEAD_CONSTS(hp); }
        const int C = cbase + chl;
        {
            const int vec = tid & 15, t0 = tid >> 4, c = cbase + vec * 8;
            float xcA[2][8], vaccA[2][8];
            { const f32x4 b0 = *(const LAS f32x4*)(CW + 4 * 128 + vec * 8), b1 = *(const LAS f32x4*)(CW + 4 * 128 + vec * 8 + 4);
#pragma unroll
              for (int i = 0; i < 2; ++i)
#pragma unroll
                for (int j = 0; j < 4; ++j) { xcA[i][j] = b0[j]; xcA[i][4 + j] = b1[j]; vaccA[i][j] = 0.f; vaccA[i][4 + j] = 0.f; } }
#pragma unroll
            for (int k = 0; k < 4; ++k) {
                const f32x4 wa = *(const LAS f32x4*)(CW + k * 128 + vec * 8), wb = *(const LAS f32x4*)(CW + k * 128 + vec * 8 + 4);
#pragma unroll
                for (int i = 0; i < 2; ++i) {
                    float xv[8]; unpack8(xr_[i + k], xv);
#pragma unroll
                    for (int j = 0; j < 4; ++j) { xcA[i][j] += wa[j] * xv[j]; xcA[i][4 + j] += wb[j] * xv[4 + j]; }
                }
            }
#pragma unroll
            for (int k = 0; k < 3; ++k) {
                const f32x4 wa = *(const LAS f32x4*)(CW + (5 + k) * 128 + vec * 8), wb = *(const LAS f32x4*)(CW + (5 + k) * 128 + vec * 8 + 4);
#pragma unroll
                for (int i = 0; i < 2; ++i) {
                    float pv[8]; unpack8(pr_[i + k], pv);
#pragma unroll
                    for (int j = 0; j < 4; ++j) { vaccA[i][j] += wa[j] * pv[j]; vaccA[i][4 + j] += wb[j] * pv[4 + j]; }
                }
            }
#pragma unroll
            for (int i = 0; i < 2; ++i) {
                const int t = 2 * t0 + i; const bool valid = t < ntok;
                float (&xc)[8] = xcA[i]; float (&vacc)[8] = vaccA[i];
                if (valid) {
                    *(LAS u32x4*)(XC + t * XC_LD + vec * 8) = pack8(xc);
                    float bv[8]; unpack8(bc_[i], bv);
#pragma unroll
                    for (int j = 0; j < 8; ++j) bv[j] *= vacc[j];
                    *(u32x4*)(P + (size_t)(row0 + t) * DIN + 2048 + c) = pack8(bv);
                    int jr = -1; float* orc = nullptr; float* osc = nullptr;
                    if (type == 1 && chunk == 31) { jr = t - 61; orc = out + O_RCP + ((size_t)l * NSEQ + seq) * 3 * D; osc = out + O_SCP + ((size_t)l * NSEQ + seq) * 2 * D; }
                    else if (type == 2) { const int b = chunk * 16 + (t >> 2); jr = (t & 3) - 1; orc = out + O_RCS + ((size_t)l * NDEC + b) * 3 * D; osc = out + O_SCS + ((size_t)l * NDEC + b) * 2 * D; }
                    if (jr >= 0) { float xcur[8]; unpack8(xr_[3 + i], xcur);
                        float* o = orc + (size_t)jr * D + c;
                        *(f32x4*)o = (f32x4){xcur[0], xcur[1], xcur[2], xcur[3]}; *(f32x4*)(o + 4) = (f32x4){xcur[4], xcur[5], xcur[6], xcur[7]}; }
                    if (jr >= 1) { float pv[8]; unpack8(pr_[2 + i], pv);
                        float* o = osc + (size_t)(jr - 1) * D + c;
                        *(f32x4*)o = (f32x4){pv[0], pv[1], pv[2], pv[3]}; *(f32x4*)(o + 4) = (f32x4){pv[4], pv[5], pv[6], pv[7]}; }
                } else {
                    *(LAS u32x4*)(XC + t * XC_LD + vec * 8) = (u32x4){0u, 0u, 0u, 0u};
                }
            }
        }
        u32x4 gw[2];
        { const int vec = tid & 15, t0 = tid >> 4, c = cbase + vec * 8;
#pragma unroll
          for (int i = 0; i < 2; ++i) { const int t = 2 * t0 + i; gw[i] = *(const u32x4*)(P + (size_t)((t < ntok) ? (row0 + t) : (MPAD - 1)) * DIN + 1024 + c); } }
        __syncthreads();

        {
            bf16x8 Bf[2][2];
#pragma unroll
            for (int g = 0; g < 2; ++g)
#pragma unroll
                for (int ks = 0; ks < 2; ++ks) Bf[g][ks] = *(const LAS bf16x8*)(GWL + (hl * 128 + g * 64 + cgi * 16 + fr) * 72 + ks * 32 + fq * 8);
            const int nmt = (type == 0) ? 1 : 4;
            float Pl[4][4], Hl[4][4];
            float cP = 1.f, cH = 0.f;
#pragma unroll
            for (int mt = 0; mt < 4; ++mt) {
                if (mt < nmt) {
                    f32x4 ar = (f32x4){0.f, 0.f, 0.f, 0.f}, ai = (f32x4){0.f, 0.f, 0.f, 0.f};
#pragma unroll
                    for (int ks = 0; ks < 2; ++ks) {
                        const bf16x8 Af = *(const LAS bf16x8*)(XC + (mt * 16 + fr) * XC_LD + hl * 64 + ks * 32 + fq * 8);
                        ar = __builtin_amdgcn_mfma_f32_16x16x32_bf16(Af, Bf[0][ks], ar, 0, 0, 0);
                        ai = __builtin_amdgcn_mfma_f32_16x16x32_bf16(Af, Bf[1][ks], ai, 0, 0, 0);
                    }
                    float av[4], uv[4];
#pragma unroll
                    for (int r = 0; r < 4; ++r) {
                        const float rg = sigmoidf_(ar[r] + bav), ig = sigmoidf_(ai[r] + bxv);
                        const float la = -8.0f * rg * spv;
                        const float x2 = 2.0f * la;
                        const float em = (x2 > -0.05f) ? -x2 * (1.0f + x2 * (0.5f + x2 * (0.16666667f + x2 * 0.041666667f))) : 1.0f - __builtin_amdgcn_exp2f(1.4426950408889634f * x2);
                        av[r] = __builtin_amdgcn_exp2f(1.4426950408889634f * la);
                        const float xcv = bf2f(XC[(mt * 16 + fq * 4 + r) * XC_LD + chl]);
                        uv[r] = __builtin_amdgcn_sqrtf(fmaxf(em, 1e-12f)) * ig * xcv;
                    }
                    if (type == 2) {
                        const int b = chunk * 16 + mt * 4 + fq;
                        float h = st_h[(size_t)b * D + C];
#pragma unroll
                        for (int r = 0; r < 4; ++r) { h = av[r] * h + uv[r]; Hl[mt][r] = h; Pl[mt][r] = 0.f; }
                        out[O_HS + ((size_t)l * NDEC + b) * D + C] = h;
                    } else {
                        float pp[4], hh[4];
                        pp[0] = av[0]; hh[0] = uv[0];
#pragma unroll
                        for (int r = 1; r < 4; ++r) { pp[r] = pp[r - 1] * av[r]; hh[r] = av[r] * hh[r - 1] + uv[r]; }
                        float ap = pp[3], ah = hh[3];
                        float tp = __shfl_up(ap, 16), th = __shfl_up(ah, 16);
                        if (fq >= 1) { ah = ap * th + ah; ap = ap * tp; }
                        tp = __shfl_up(ap, 32); th = __shfl_up(ah, 32);
                        if (fq >= 2) { ah = ap * th + ah; ap = ap * tp; }
                        float ep = __shfl_up(ap, 16), eh = __shfl_up(ah, 16);
                        if (fq == 0) { ep = 1.f; eh = 0.f; }
                        const float bp = cP * ep, bh = ep * cH + eh;
#pragma unroll
                        for (int r = 0; r < 4; ++r) { Pl[mt][r] = bp * pp[r]; Hl[mt][r] = pp[r] * bh + hh[r]; }
                        tp = __shfl(ap, 48 + fr); th = __shfl(ah, 48 + fr);
                        cH = tp * cH + th; cP = cP * tp;
                    }
                } else {
#pragma unroll
                    for (int r = 0; r < 4; ++r) { Pl[mt][r] = 0.f; Hl[mt][r] = 0.f; }
                }
            }
            if (type != 2) {
                const int slot = (type == 0) ? 0 : (1 + seq * 32 + chunk);
                if (fq == 0) __hip_atomic_store(agg + (size_t)slot * D + C, ((u64)__float_as_uint(cH) << 32) | (u64)__float_as_uint(cP), __ATOMIC_RELAXED, __HIP_MEMORY_SCOPE_AGENT);
                float carry = 0.f;
                if (type == 1) {
                    const int npred = chunk + 1, cnt = (npred + 3) >> 2, jb = fq * cnt;
                    u64 v[8];
                    unsigned spins = 0;
                    for (;;) {
                        bool ok = true;
#pragma unroll
                        for (int i = 0; i < 8; ++i) {
                            const int j = jb + i;
                            if (i < cnt && j < npred) {
                                const int sl = (j == 0) ? 0 : (seq * 32 + j);
                                v[i] = __hip_atomic_load(agg + (size_t)sl * D + C, __ATOMIC_RELAXED, __HIP_MEMORY_SCOPE_AGENT);
                                ok = ok && ((unsigned)v[i] != 0xFFFFFFFFu);
                            } else v[i] = 0ull;
                        }
                        if (__all(ok)) break;
                        if (++spins > 200000u) break;
                        __builtin_amdgcn_s_sleep(2);
                    }
                    float Ag = 1.f, Hg = 0.f;
#pragma unroll
                    for (int i = 0; i < 8; ++i) {
                        const int j = jb + i;
                        if (i < cnt && j < npred) { const float A = __uint_as_float((unsigned)v[i]), H = __uint_as_float((unsigned)(v[i] >> 32)); Hg = A * Hg + H; Ag = A * Ag; }
                    }
#pragma unroll
                    for (int q = 0; q < 4; ++q) { const float Aq = __shfl(Ag, q * 16 + fr), Hq = __shfl(Hg, q * 16 + fr); carry = Aq * carry + Hq; }
                }
#pragma unroll
                for (int mt = 0; mt < 4; ++mt)
#pragma unroll
                    for (int r = 0; r < 4; ++r) Hl[mt][r] = Hl[mt][r] + Pl[mt][r] * carry;
                if (type == 1 && chunk == 31 && fq == 3) out[O_HP + ((size_t)l * NSEQ + seq) * D + C] = Hl[3][3];
            }
        if (tile + nwg < N_MIX_TILES) {
            MIX_DECODE(tile + nwg, n_type, n_row0, n_hp, n_chunk, n_seq, n_ntok);
            const int type = n_type, row0 = n_row0, chunk = n_chunk, ntok = n_ntok, cbase = n_hp * 128;
            const int vec = tid & 15, t0 = tid >> 4, c = cbase + vec * 8;
            {
                const int tb = 2 * t0; const bool valid = tb < ntok;
#pragma unroll
                for (int j = 0; j < 5; ++j) {
                    const int d = ((type == 2) ? (tb & 3) : tb) - 3 + j;
                    int row = row0 + tb - 3 + j;
                    if (d < 0) row = (type == 0) ? (MPAD - 1) : ((chunk > 0) ? row : (META_ROW0 + NMETA + d));
                    if (!valid) row = MPAD - 1;
                    if (type == 2 && d < 0) {
                        const int b = chunk * 16 + (tb >> 2);
                        const float* sp = st_rc + ((size_t)b * 3 + (d + 3)) * D + c;
                        const f32x4 s0 = *(const f32x4*)sp, s1 = *(const f32x4*)(sp + 4);
                        xr_[j] = (u32x4){cvt_pk_bf16(s0[0], s0[1]), cvt_pk_bf16(s0[2], s0[3]), cvt_pk_bf16(s1[0], s1[1]), cvt_pk_bf16(s1[2], s1[3])};
                        if (j >= 1) {
                            const float* sq = st_sc + ((size_t)b * 2 + (d + 2)) * D + c;
                            const f32x4 q0 = *(const f32x4*)sq, q1 = *(const f32x4*)(sq + 4);
                            pr_[j - 1] = (u32x4){cvt_pk_bf16(q0[0], q0[1]), cvt_pk_bf16(q0[2], q0[3]), cvt_pk_bf16(q1[0], q1[1]), cvt_pk_bf16(q1[2], q1[3])};
                        }
                    } else {
                        const bf16_t* rp = P + (size_t)row * DIN + c;
                        xr_[j] = *(const u32x4*)rp;
                        if (j >= 1) pr_[j - 1] = *(const u32x4*)(rp + 3072);
                        if (j >= 3) bc_[j - 3] = *(const u32x4*)(rp + 2048);
                    }
                }
            }
        }
#pragma unroll
            for (int mt = 0; mt < 4; ++mt)
#pragma unroll
                for (int r = 0; r < 4; ++r) HB[(mt * 16 + fq * 4 + r) * HB_LD + chl] = Hl[mt][r];
        }
        __syncthreads();

        {
            const int vec = tid & 15, t0 = tid >> 4, c = cbase + vec * 8;
#pragma unroll
            for (int i = 0; i < 2; ++i) {
                const int t = 2 * t0 + i;
                if (t < ntok) {
                    float gv[8]; unpack8(gw[i], gv);
                    const f32x4 h0 = *(const LAS f32x4*)(HB + t * HB_LD + vec * 8), h1 = *(const LAS f32x4*)(HB + t * HB_LD + vec * 8 + 4);
                    float o[8];
#pragma unroll
                    for (int j = 0; j < 4; ++j) { o[j] = h0[j] * gelu_tanh(gv[j]); o[4 + j] = h1[j] * gelu_tanh(gv[4 + j]); }
                    *(u32x4*)(P + (size_t)(row0 + t) * DIN + 1024 + c) = pack8(o);
                }
            }
        }
    }
    __syncthreads();
}


#define XB_TMO      128
#define XB_XCNT(j)  (256  + 64 * (j))
#define XB_XSUB(j)  (1280 + 64 * (j))
#define XB_XGEN(j)  (2304 + 64 * (j))
#define XB_TOP      3328
#define XB_TOPGEN   3392
#define XCD_BAR_WORDS 3456
#define XB_SPIN_CAP (1u << 20)
__device__ __forceinline__ unsigned xb_ld(unsigned* p)              { return __hip_atomic_load(p, __ATOMIC_RELAXED, __HIP_MEMORY_SCOPE_AGENT); }
__device__ __forceinline__ unsigned xb_add(unsigned* p, unsigned v) { return __hip_atomic_fetch_add(p, v, __ATOMIC_RELAXED, __HIP_MEMORY_SCOPE_AGENT); }
__device__ __forceinline__ unsigned xb_xcc_id() { return (unsigned)__builtin_amdgcn_s_getreg((3 << 11) | 20) & 0xFu; }
#define XB_SPIN(cond, bar) do { unsigned _sp = 0; while (cond) { __builtin_amdgcn_s_sleep(1); \
    if ((++_sp & 255u) == 0u) { if (xb_ld(&(bar)[XB_TMO])) break; if (_sp > XB_SPIN_CAP) { atomicAdd(&(bar)[XB_TMO], 1u); break; } } } } while (0)
struct XcdBarrier { unsigned* bar; unsigned x; volatile LAS unsigned* st; };
__device__ __forceinline__ XcdBarrier xcd_barrier_post(unsigned* bar, volatile LAS unsigned* st) {
    XcdBarrier b; b.bar = bar; b.x = xb_xcc_id(); b.st = st;
    if (threadIdx.x == 0) (void)xb_add(&bar[XB_XCNT(b.x)], 1u);
    return b;
}
__device__ __forceinline__ void xcd_barrier_complete(unsigned* bar, unsigned x, unsigned& nloc, unsigned& nx) {
    const unsigned G = gridDim.x * gridDim.y * gridDim.z;
    unsigned sum, cnt, mine, sp = 0u;
    for (;;) {
        sum = 0u; cnt = 0u; mine = 0u;
#pragma unroll
        for (unsigned j = 0; j < 16; ++j) { const unsigned c = xb_ld(&bar[XB_XCNT(j)]); sum += c; cnt += (c > 0u) ? 1u : 0u; mine = (j == x) ? c : mine; }
        if (sum == G) break;
        __builtin_amdgcn_s_sleep(1);
        if ((++sp & 255u) == 0u) { if (xb_ld(&bar[XB_TMO])) break; if (sp > XB_SPIN_CAP) { atomicAdd(&bar[XB_TMO], 1u); break; } }
    }
    nloc = mine > 0u ? mine : 1u; nx = cnt > 0u ? cnt : 1u;
}
__device__ __forceinline__ void xcd_barrier(const XcdBarrier& b) {
    asm volatile("s_waitcnt vmcnt(0)" ::: "memory");
    __syncthreads();
    if (threadIdx.x == 0) {
        unsigned* bar = b.bar;
        __builtin_amdgcn_s_waitcnt(0);
        unsigned nloc = b.st[0], nx = b.st[1];
        if (nloc == 0u) { xcd_barrier_complete(bar, b.x, nloc, nx); b.st[0] = nloc; b.st[1] = nx; }
        const unsigned old = xb_add(&bar[XB_XSUB(b.x)], 1u);
        const unsigned gen = old / nloc;
        if (old + 1u == (gen + 1u) * nloc) {
            __builtin_amdgcn_fence(__ATOMIC_RELEASE, "agent");
            asm volatile("s_waitcnt vmcnt(0)" ::: "memory");
            const unsigned og = xb_add(&bar[XB_TOP], 1u);
            const unsigned tg = og / nx;
            if (og + 1u == (tg + 1u) * nx) xb_add(&bar[XB_TOPGEN], 1u);
            else XB_SPIN(xb_ld(&bar[XB_TOPGEN]) == tg, bar);
            __builtin_amdgcn_fence(__ATOMIC_ACQUIRE, "agent");
            xb_add(&bar[XB_XGEN(b.x)], 1u);
            asm volatile("s_waitcnt vmcnt(0)" ::: "memory");
        } else {
            XB_SPIN(xb_ld(&bar[XB_XGEN(b.x)]) == gen, bar);
            __builtin_amdgcn_fence(__ATOMIC_ACQUIRE, "agent");
            asm volatile("s_waitcnt vmcnt(0)" ::: "memory");
        }
    }
    __syncthreads();
}

__global__ void __launch_bounds__(NT, 2) fwd_megakernel(Params p) {
    extern __shared__ __attribute__((aligned(16))) unsigned char lds_raw[];
    LAS unsigned char* lds = (LAS unsigned char*)lds_raw;
    cg::grid_group grid = cg::this_grid();
    const int tid = threadIdx.x, wg = blockIdx.x, nwg = gridDim.x;
#ifdef PROBE_MODE
    unsigned long long tacc = 0, tmark = 0;
#define PB_BEGIN(k) do { if (PROBE_MODE == (k)) tmark = __builtin_amdgcn_s_memrealtime(); } while (0)
#define PB_END(k) do { if (PROBE_MODE == (k)) tacc += __builtin_amdgcn_s_memrealtime() - tmark; } while (0)
#define PB_ADD(k, v) do { if (PROBE_MODE == (k)) tacc += (v); } while (0)
#else
#define PB_ADD(k, v) do { (void)(v); } while (0)
#define PB_BEGIN(k) do {} while (0)
#define PB_END(k) do {} while (0)
#endif
#define GSYNC() do { PB_BEGIN(2); xcd_barrier(xbar); PB_END(2); } while (0)
    unsigned char* ws = p.ws;
    bf16_t* P = (bf16_t*)(ws + OFF_P);
    float* X = (float*)(ws + OFF_X);
    bf16_t* XB = (bf16_t*)(ws + OFF_XB);
    float* RS1 = (float*)(ws + OFF_RS1);
    float* RS2 = (float*)(ws + OFF_RS2);

    volatile LAS unsigned* bst = (volatile LAS unsigned*)(lds + 128 * 1024);
    if (tid < 4) bst[tid] = 0u;
    __syncthreads();
    const XcdBarrier xbar = xcd_barrier_post((unsigned*)(ws + OFF_BAR), bst);
#ifndef NO_CVT
    convert_layer(p, 0, (bf16_t*)(ws + OFF_W), lds, tid, wg, nwg, 0, CV_T8);
#endif
    { int tid0 = threadIdx.x; asm volatile("" : "+v"(tid0)); const int wid = tid0 >> 6, lane = tid0 & 63;
#pragma unroll 2
    for (int row = wg * 8 + wid; row < MPAD; row += nwg * 8) {
        const float* src = nullptr;
        if (row < SAMPLE_ROW0) src = in_ptr(0) + (size_t)row * D;
        else if (row < META_ROW0) src = in_ptr(1) + (size_t)(row - SAMPLE_ROW0) * D;
        else if (row < META_ROW0 + NMETA) src = in_ptr(5) + (size_t)(row - META_ROW0) * D;
        float ss = 0.f;
#pragma unroll
        for (int i = 0; i < 4; ++i) {
            const int c = i * 256 + lane * 4;
            f32x4 v = (f32x4){0.f, 0.f, 0.f, 0.f};
            if (src) v = *(const f32x4*)(src + c);
            u32x2 w; w.x = cvt_pk_bf16(v[0], v[1]); w.y = cvt_pk_bf16(v[2], v[3]);
            *(u32x2*)(XB + (size_t)row * D + c) = w;
            ss += (v[0] * v[0] + v[1] * v[1]) + (v[2] * v[2] + v[3] * v[3]);
        }
#pragma unroll
        for (int o = 32; o >= 1; o >>= 1) ss += __shfl_xor(ss, o);
        if (lane < 32) RS1[(size_t)row * 32 + lane] = (lane == 0) ? ss : 0.f;
    }
    }
    {
        u32x4* a = (u32x4*)(ws + OFF_AGG);
        const size_t n16 = AGG_BYTES / 16;
        for (size_t i = (size_t)wg * NT + tid; i < n16; i += (size_t)nwg * NT) a[i] = (u32x4){0xFFFFFFFFu, 0xFFFFFFFFu, 0xFFFFFFFFu, 0xFFFFFFFFu};
    }
    grid.sync();

    for (int l = 0; l < DEPTH; ++l) {
        const bf16_t* wset = (const bf16_t*)(ws + OFF_W + (size_t)(l & 1) * WSET_BYTES);
        const bf16_t* W1 = wset; const bf16_t* WAB = W1 + W1_E; const bf16_t* WO2 = WAB + WAB_E; const bf16_t* WGU = WO2 + WO2_E; const bf16_t* WD = WGU + WGU_E;
        {
            pg8::Gemm g{XB, W1, MPAD, DIN, D, D, 1 << 30, 0}; pg8::StaticOrder S; S.init(MPAD, DIN, nwg, wg);
            EpiP E{P, RS1};
            PB_BEGIN(4);
            { const unsigned long long et_ = pg8::gemm_phase<EpiP>(lds, g, S, E); PB_ADD(6, et_); }
            PB_END(4);
            { const int nlast = (MPAD / 256) * (DIN / 256) - 7 * nwg;
              const bool part = nlast > 0 && nlast < nwg;
              const int cw = part ? wg - nlast : wg, cn = part ? nwg - nlast : nwg;
              if (l + 1 < DEPTH && cw >= 0) convert_layer(p, l + 1, (bf16_t*)(ws + OFF_W + (size_t)((l + 1) & 1) * WSET_BYTES), lds, tid, cw, cn, 0, part ? CV_SPLIT : CV_T8); }
        }
        GSYNC();
        PB_BEGIN(1); PB_BEGIN(3);
        PB_END(3);
#ifndef NO_MIXER
        mixer_phase(p, l, lds, tid, wg, nwg);
#endif
        PB_END(1);
        GSYNC();
        {
            pg8::Gemm g{P + 1024, WAB, SAMPLE_ROW0, D, 2048, DIN, 1 << 30, 0}; pg8::StaticOrder S; S.init(SAMPLE_ROW0, D, nwg, wg);
            EpiM E{P};
            { const unsigned long long et_ = pg8::gemm_phase<EpiM>(lds, g, S, E); PB_ADD(6, et_); }
            MiniM EM{P};
            mini_phase<MiniM>(lds, P + 1024, DIN, 1 << 30, 0, WAB, 2048, 32, EM, tid, wg, nwg);
        }
        GSYNC();
        {
            pg8::Gemm g{P + 3072, WO2, SAMPLE_ROW0, D, D, DIN, 1 << 30, 0}; pg8::StaticOrder S; S.init(SAMPLE_ROW0, D, nwg, wg);
            EpiRes E{X, XB, RS2};
            { const unsigned long long et_ = pg8::gemm_phase<EpiRes>(lds, g, S, E); PB_ADD(6, et_); }
            MiniRes EM{X, XB, RS2};
            mini_phase<MiniRes>(lds, P + 3072, DIN, 1 << 30, 0, WO2, D, 32, EM, tid, wg, nwg);
        }
        GSYNC();
        {
            pg8::Gemm g{XB, WGU, MPAD, 2 * DFF, D, D, 1 << 30, 0}; pg8::StaticOrder S; S.init(MPAD, 2 * DFF, nwg, wg);
            EpiGlu E{P, RS2};
#if !defined(ONLY) || ONLY==4
            { const unsigned long long et_ = pg8::gemm_phase<EpiGlu>(lds, g, S, E); PB_ADD(6, et_); }
            { const int nu5 = (MPAD / 256) * (2 * DFF / 256), nlast5 = nu5 - (nu5 / nwg) * nwg, nlast1 = (MPAD / 256) * (DIN / 256) - 7 * nwg;
              const bool part1 = nlast1 > 0 && nlast1 < nwg;
              const bool part5 = nlast5 > 0 && nlast5 < nwg;
              const int cw = part5 ? wg - nlast5 : wg, cn = part5 ? nwg - nlast5 : nwg;
              if (l + 1 < DEPTH && part1 && cw >= 0) convert_layer(p, l + 1, (bf16_t*)(ws + OFF_W + (size_t)((l + 1) & 1) * WSET_BYTES), lds, tid, cw, cn, CV_SPLIT, CV_T8); }
#endif
        }
        GSYNC();
        {
            pg8::Gemm g{P, WD, SAMPLE_ROW0, D, DFF, DIN, 1 << 30, 0}; pg8::StaticOrder S; S.init(SAMPLE_ROW0, D, nwg, wg);
            EpiRes E{X, XB, RS1};
            PB_BEGIN(5);
            { const unsigned long long et_ = pg8::gemm_phase<EpiRes>(lds, g, S, E); PB_ADD(6, et_); }
            MiniRes EM{X, XB, RS1};
            mini_phase<MiniRes>(lds, P, DIN, 1 << 30, 0, WD, DFF, 32, EM, tid, wg, nwg);
            PB_END(5);
        }
        GSYNC();
    }

    {
        int tidf = threadIdx.x; asm volatile("" : "+v"(tidf));
        const int wid = tidf >> 6, lane = tidf & 63;
        const float* gfin = in_ptr(23);
#pragma unroll 2
        for (int row = (int)blockIdx.x * 8 + wid; row < MOUT; row += (int)gridDim.x * 8) {
            const float rs = row_rs(RS1, row);
#pragma unroll
            for (int i = 0; i < 4; ++i) {
                const int c = i * 256 + lane * 4;
                const u32x2 xw = *(const u32x2*)(XB + (size_t)row * D + c);
                const f32x4 v = (f32x4){bf_lo(xw.x), bf_hi(xw.x), bf_lo(xw.y), bf_hi(xw.y)}, gg = *(const f32x4*)(gfin + c);
                *(f32x4*)(p.out + O_Y + (size_t)row * D + c) = v * rs * gg;
            }
        }
    }
#ifdef PROBE_MODE
    if (wg == 0 && tid == 0) { const unsigned long long t0 = __builtin_amdgcn_s_memrealtime(); while (__builtin_amdgcn_s_memrealtime() - t0 < tacc) __builtin_amdgcn_s_sleep(8); }
#endif
}

extern "C" void kernel_launch(void* const* d_in, const int* in_sizes, int n_in, void* d_out, int out_size, void* d_ws, size_t ws_size, hipStream_t stream) {
    static int gridn = 0;
    if (!gridn) {
        int dev = 0, cus = 0, per_cu = 0;
        (void)hipGetDevice(&dev);
        (void)hipDeviceGetAttribute(&cus, hipDeviceAttributeMultiprocessorCount, dev);
        (void)hipFuncSetAttribute((const void*)fwd_megakernel, hipFuncAttributeMaxDynamicSharedMemorySize, LDS_BYTES);
        (void)hipOccupancyMaxActiveBlocksPerMultiprocessor(&per_cu, (const void*)fwd_megakernel, NT, LDS_BYTES);
        if (per_cu < 1) { fprintf(stderr, "kernel_launch: occupancy query says %d blocks per CU\n", per_cu); per_cu = 1; }
        gridn = cus;
        if (ws_size < WS_NEED) fprintf(stderr, "kernel_launch: workspace too small: %zu < %zu\n", ws_size, (size_t)WS_NEED);
    }
    if (ws_size < WS_NEED || n_in != 24) return;
    Params p{};
    for (int i = 0; i < 24; ++i) p.in[i] = (const float*)d_in[i];
    p.out = (float*)d_out; p.ws = (unsigned char*)d_ws;
    (void)hipMemsetAsync((unsigned char*)d_ws + OFF_BAR, 0, 16384, stream);
    void* args[] = {&p};
    hipError_t e = hipLaunchCooperativeKernel((const void*)fwd_megakernel, dim3(gridn), dim3(NT), args, LDS_BYTES, stream);
    if (e != hipSuccess) fprintf(stderr, "kernel_launch: cooperative launch failed: %s (grid %d)\n", hipGetErrorString(e), gridn);
}
```

```cpp
#include <hip/hip_runtime.h>
#include <hip/hip_cooperative_groups.h>
#include <cstdio>
namespace cg = cooperative_groups;

#define LAS __attribute__((address_space(3)))
typedef unsigned short bf16_t;
typedef short bf16x8 __attribute__((ext_vector_type(8)));
typedef float f32x4 __attribute__((ext_vector_type(4)));
typedef unsigned u32x4 __attribute__((ext_vector_type(4)));
typedef unsigned u32x2 __attribute__((ext_vector_type(2)));
typedef unsigned long long u64;

constexpr int D = 1024, DIN = 7168, DFF = 2816, DEPTH = 4;
constexpr int NSEQ = 8, SEQ = 2048, NDEC = 128, DECT = 4, NMETA = 16;
constexpr int SAMPLE_ROW0 = NSEQ * SEQ;
constexpr int META_ROW0 = SAMPLE_ROW0 + NDEC * DECT;
constexpr int MOUT = META_ROW0;
constexpr int MPAD = 17152;
constexpr float EPS = 1e-6f;
constexpr int NT = 512;
constexpr int LDS_BYTES = 128 * 1024 + 16;

constexpr size_t P_BYTES = (size_t)MPAD * DIN * 2;
constexpr size_t X_BYTES = (size_t)MPAD * D * 4;
constexpr size_t XB_BYTES = (size_t)MPAD * D * 2;
constexpr size_t W1_E = (size_t)DIN * D, WAB_E = (size_t)2048 * D, WO2_E = (size_t)D * 2048, WGU_E = (size_t)2 * DFF * D, WD_E = (size_t)D * DFF, WG_E = (size_t)16 * 128 * 64;
constexpr size_t WSET_E = W1_E + WAB_E + WO2_E + WGU_E + WD_E + WG_E;
constexpr size_t WSET_BYTES = WSET_E * 2;
constexpr int NSLOT = 1 + NSEQ * 32;
constexpr size_t AGG_BYTES = (size_t)DEPTH * NSLOT * D * 8;
constexpr size_t OFF_P = 0, OFF_X = OFF_P + P_BYTES, OFF_XB = OFF_X + X_BYTES, OFF_W = OFF_XB + XB_BYTES, OFF_RS1 = OFF_W + 2 * WSET_BYTES,
                 OFF_RS2 = OFF_RS1 + (size_t)MPAD * 128, OFF_AGG = OFF_RS2 + (size_t)MPAD * 128, OFF_BAR = OFF_AGG + AGG_BYTES, WS_NEED = OFF_BAR + 16384;

constexpr size_t O_Y = 0, O_HP = (size_t)MOUT * D, O_RCP = O_HP + (size_t)DEPTH * NSEQ * D, O_SCP = O_RCP + (size_t)DEPTH * NSEQ * 3 * D,
                 O_HS = O_SCP + (size_t)DEPTH * NSEQ * 2 * D, O_RCS = O_HS + (size_t)DEPTH * NDEC * D, O_SCS = O_RCS + (size_t)DEPTH * NDEC * 3 * D;

struct Params {
    const float* in[24];
    float* out;
    unsigned char* ws;
};

__device__ __forceinline__ const float* in_ptr(int i) {
    const __attribute__((address_space(4))) char* ka = (const __attribute__((address_space(4))) char*)__builtin_amdgcn_kernarg_segment_ptr();
    return *(const float* const volatile __attribute__((address_space(4)))*)(ka + 8 * i);
}

__device__ __forceinline__ unsigned cvt_pk_bf16(float lo, float hi) { unsigned r; asm volatile("v_cvt_pk_bf16_f32 %0, %1, %2" : "=v"(r) : "v"(lo), "v"(hi)); return r; }
__device__ __forceinline__ float bf_lo(unsigned w) { return __uint_as_float(w << 16); }
__device__ __forceinline__ float bf_hi(unsigned w) { return __uint_as_float(w & 0xffff0000u); }
__device__ __forceinline__ float bf2f(bf16_t b) { return __uint_as_float(((unsigned)b) << 16); }
__device__ __forceinline__ float sigmoidf_(float x) { return __builtin_amdgcn_rcpf(1.0f + __builtin_amdgcn_exp2f(-1.4426950408889634f * x)); }
__device__ __forceinline__ void unpack8(const u32x4 w, float (&f)[8]) {
    f[0] = bf_lo(w.x); f[1] = bf_hi(w.x); f[2] = bf_lo(w.y); f[3] = bf_hi(w.y); f[4] = bf_lo(w.z); f[5] = bf_hi(w.z); f[6] = bf_lo(w.w); f[7] = bf_hi(w.w);
}
__device__ __forceinline__ u32x4 pack8(const float (&f)[8]) {
    u32x4 w; w.x = cvt_pk_bf16(f[0], f[1]); w.y = cvt_pk_bf16(f[2], f[3]); w.z = cvt_pk_bf16(f[4], f[5]); w.w = cvt_pk_bf16(f[6], f[7]); return w;
}

__device__ __forceinline__ float row_rs(const float* rsp, int row) {
    const f32x4* q = (const f32x4*)(rsp + (size_t)row * 32);
    const f32x4 s = ((q[0] + q[1]) + (q[2] + q[3])) + ((q[4] + q[5]) + (q[6] + q[7]));
    return rsqrtf(((s[0] + s[1]) + (s[2] + s[3])) * (1.0f / D) + EPS);
}

__device__ __forceinline__ float row_rs4(const float* rsp, int row, int fq) {
    const f32x4* q = (const f32x4*)(rsp + (size_t)row * 32) + 2 * fq;
    const f32x4 s = q[0] + q[1];
    float t = (s[0] + s[1]) + (s[2] + s[3]);
    t += __shfl_xor(t, 16); t += __shfl_xor(t, 32);
    return rsqrtf(t * (1.0f / D) + EPS);
}

namespace pg8 {
constexpr int BM = 256, BK = 64, HALF = 128, HTB = HALF * BK * 2, STAGE_BYTES = 8 * HTB, NXCD = 8, WGM = 8;
__device__ __forceinline__ int lds_byte(int r, int c) { const int st = (r >> 4) * 2 + (c >> 5), rr = r & 15, cc = c & 31, ob = rr * 64 + cc * 2; return st * 1024 + (ob ^ (((ob >> 9) & 1) << 5)); }
__device__ __forceinline__ void stage_rc(int b, int& R, int& C) { const int st = b / 1024, sb = b % 1024, swz = sb ^ (((sb >> 9) & 1) << 5); R = (st >> 1) * 16 + swz / 64; C = (st & 1) * 32 + (swz % 64) / 2; }
__device__ __forceinline__ int perm32(int rho) { const int n = rho >> 4, i = rho & 15; return 8 * (i >> 2) + 4 * n + (i & 3); }

struct Unit { int pm, pn; };
struct Gemm { const bf16_t* A; const bf16_t* Bt; int M, N, K, lda; int split_pn; int split_off; };

struct StaticOrder {
    int nM, nN, nwg, G, c;
    __device__ void init(int M, int N, int G_, int c_) { nM = M / BM; nN = N / BM; nwg = nM * nN; G = G_; c = c_; }
    __device__ bool next(int i, Unit& u) const {
        const long L = (long)i * G + c; if (L >= nwg) return false;
        int wgid = (int)L; { const int q = nwg / NXCD, r = nwg % NXCD, xcd = wgid % NXCD, off = wgid / NXCD; wgid = (xcd < r ? xcd * (q + 1) : r * (q + 1) + (xcd - r) * q) + off; }
        const int nig = WGM * nN, gid = wgid / nig, fm = gid * WGM, gsz = (nM - fm) < WGM ? (nM - fm) : WGM;
        u.pm = fm + ((wgid % nig) % gsz); u.pn = (wgid % nig) / gsz; return true;
    }
};

template <class Epi>
__device__ __forceinline__ unsigned long long gemm_phase(LAS unsigned char* lds, const Gemm g, const StaticOrder& S, const Epi& E) {
    unsigned long long epi_ticks = 0;
    int tid_ = threadIdx.x; asm volatile("" : "+v"(tid_));
    const int tid = tid_, wid = __builtin_amdgcn_readfirstlane(tid >> 6), lane = tid & 63, wr = wid >> 2, wc = wid & 3, fr = lane & 15, fq = lane >> 4;
    const int K = g.K, nt = K / BK, lda = g.lda;
    unsigned voffA[2], voffB[2];
#pragma unroll
    for (int i = 0; i < 2; ++i) { int R, C; stage_rc(tid * 16 + i * 8192, R, C); voffA[i] = (unsigned)(R * lda + C) * 2u; voffB[i] = (unsigned)(R * K + C) * 2u; }
    const size_t kstep = (size_t)(BK * 2);
    const size_t hstepA = (size_t)HALF * lda * 2, hstepB = (size_t)HALF * K * 2;
    const size_t tstepA = 2 * hstepA, tstepB = 2 * hstepB;
    const unsigned ldsw = (unsigned)wid * 1024u;
    const int aoff = lds_byte(wr * 64 + fr, fq * 8), boff = lds_byte(wc * 32 + fr, fq * 8);
#define PG8_SA(b, h) (((b) * 2 + (h)) * HTB)
#define PG8_SB(b, h) ((4 + (b) * 2 + (h)) * HTB)
#define PG8_STAGE(bufoff, gbase, voff) do { _Pragma("unroll") for (int _i = 0; _i < 2; ++_i) \
        __builtin_amdgcn_global_load_lds((const unsigned*)((const char*)(gbase) + (voff)[_i]), (LAS unsigned*)(lds + (bufoff) + ldsw + _i * 8192), 16, 0, 0); } while (0)
#define PG8_LDA(dst, b, h) do { _Pragma("unroll") for (int m = 0; m < 4; ++m) _Pragma("unroll") for (int k = 0; k < 2; ++k) dst[m][k] = *(const LAS bf16x8*)(lds + PG8_SA(b, h) + aoff + m * 2048 + k * 1024); } while (0)
#define PG8_LDB(dst, b, h) do { _Pragma("unroll") for (int n = 0; n < 2; ++n) _Pragma("unroll") for (int k = 0; k < 2; ++k) dst[n][k] = *(const LAS bf16x8*)(lds + PG8_SB(b, h) + boff + n * 2048 + k * 1024); } while (0)
#define PG8_MMA(ai, bj, At, Bt) do { __builtin_amdgcn_s_setprio(1); _Pragma("unroll") for (int m = 0; m < 4; ++m) _Pragma("unroll") for (int n = 0; n < 2; ++n) _Pragma("unroll") for (int k = 0; k < 2; ++k) \
        acc[ai][bj][m][n] = __builtin_amdgcn_mfma_f32_16x16x32_bf16(Bt[n][k], At[m][k], acc[ai][bj][m][n], 0, 0, 0); __builtin_amdgcn_s_setprio(0); } while (0)
#define PG8_WAIT_V(n) asm volatile("s_waitcnt vmcnt(" #n ")" ::: "memory")
#define PG8_WAIT_L(n) asm volatile("s_waitcnt lgkmcnt(" #n ")" ::: "memory")
#define PG8_BAR __builtin_amdgcn_s_barrier()
#define PG8_SCHED __builtin_amdgcn_sched_barrier(0)
    Unit cur, nxt; int ui = 0;
    if (!S.next(0, cur)) return 0;
    f32x4 acc[2][2][4][2];
#pragma unroll
    for (int a = 0; a < 2; ++a)
#pragma unroll
        for (int b = 0; b < 2; ++b)
#pragma unroll
            for (int m = 0; m < 4; ++m)
#pragma unroll
                for (int n = 0; n < 2; ++n) acc[a][b][m][n] = (f32x4){0.f, 0.f, 0.f, 0.f};
    bf16x8 At[4][2], B0[2][2], B1[2][2];
    const char* cA = (const char*)g.A + (size_t)cur.pm * tstepA + (cur.pn >= g.split_pn ? g.split_off : 0); const char* cB = (const char*)g.Bt + (size_t)cur.pn * tstepB;
    PG8_STAGE(PG8_SB(0, 0), cB, voffB); PG8_STAGE(PG8_SA(0, 0), cA, voffA); PG8_STAGE(PG8_SB(0, 1), cB + hstepB, voffB); PG8_STAGE(PG8_SA(0, 1), cA + hstepA, voffA);
    if (wr == 1) PG8_BAR;
    PG8_WAIT_V(4); PG8_BAR;
    PG8_STAGE(PG8_SB(1, 0), cB + kstep, voffB); PG8_STAGE(PG8_SA(1, 0), cA + kstep, voffA); PG8_STAGE(PG8_SB(1, 1), cB + hstepB + kstep, voffB);
    PG8_WAIT_V(6); PG8_BAR;
    for (;;) {
        const bool has_next = S.next(ui + 1, nxt);
        const char* nA = has_next ? (const char*)g.A + (size_t)nxt.pm * tstepA + (nxt.pn >= g.split_pn ? g.split_off : 0) : cA; const char* nB = has_next ? (const char*)g.Bt + (size_t)nxt.pn * tstepB : cB;
#define PG8_KTRIP(t) do { \
            const bool last = (t == nt - 2); \
            const char* a1 = cA + (size_t)(t + 1) * kstep; \
            const char* a2 = last ? nA : cA + (size_t)(t + 2) * kstep; const char* b2 = last ? nB : cB + (size_t)(t + 2) * kstep; \
            const char* a3 = a2 + kstep; const char* b3 = b2 + kstep; \
            PG8_LDB(B0, 0, 0); PG8_SCHED; PG8_LDA(At, 0, 0); PG8_STAGE(PG8_SA(1, 1), a1 + hstepA, voffA); \
            PG8_WAIT_L(8); PG8_BAR; PG8_WAIT_L(0); PG8_MMA(0, 0, At, B0); PG8_BAR; PG8_SCHED; \
            PG8_LDB(B1, 0, 1); PG8_STAGE(PG8_SB(0, 0), b2, voffB); \
            PG8_BAR; PG8_WAIT_L(0); PG8_MMA(0, 1, At, B1); PG8_BAR; \
            PG8_LDA(At, 0, 1); PG8_STAGE(PG8_SA(0, 0), a2, voffA); \
            PG8_BAR; PG8_WAIT_L(0); PG8_MMA(1, 0, At, B0); PG8_BAR; PG8_SCHED; \
            PG8_STAGE(PG8_SB(0, 1), b2 + hstepB, voffB); \
            PG8_WAIT_V(6); PG8_BAR; PG8_MMA(1, 1, At, B1); PG8_BAR; \
            PG8_LDB(B0, 1, 0); PG8_SCHED; PG8_LDA(At, 1, 0); PG8_STAGE(PG8_SA(0, 1), a2 + hstepA, voffA); \
            PG8_WAIT_L(8); PG8_BAR; PG8_WAIT_L(0); PG8_MMA(0, 0, At, B0); PG8_BAR; PG8_SCHED; \
            PG8_LDB(B1, 1, 1); PG8_STAGE(PG8_SB(1, 0), b3, voffB); \
            PG8_BAR; PG8_WAIT_L(0); PG8_MMA(0, 1, At, B1); PG8_BAR; \
            PG8_LDA(At, 1, 1); PG8_STAGE(PG8_SA(1, 0), a3, voffA); \
            PG8_BAR; PG8_WAIT_L(0); PG8_MMA(1, 0, At, B0); PG8_BAR; PG8_SCHED; \
            PG8_STAGE(PG8_SB(1, 1), b3 + hstepB, voffB); \
            PG8_WAIT_V(6); PG8_BAR; PG8_MMA(1, 1, At, B1); PG8_BAR; \
        } while (0)
        if constexpr (Epi::MIDK) {
            for (int t = 0; t < (nt >> 1); t += 2) PG8_KTRIP(t);
            E.mid(acc, cur, wr, wc, fr, fq);
            for (int t = (nt >> 1); t < nt; t += 2) PG8_KTRIP(t);
        } else {
            for (int t = 0; t < nt; t += 2) PG8_KTRIP(t);
        }
#undef PG8_KTRIP
#ifdef PROBE_MODE
        const unsigned long long te0 = __builtin_amdgcn_s_memrealtime();
#endif
        E(acc, cur, wr, wc, fr, fq);
#ifdef PROBE_MODE
        asm volatile("s_waitcnt vmcnt(0)" ::: "memory"); epi_ticks += __builtin_amdgcn_s_memrealtime() - te0;
#endif
        if (!has_next) break;
#pragma unroll
        for (int a = 0; a < 2; ++a)
#pragma unroll
            for (int b = 0; b < 2; ++b)
#pragma unroll
                for (int m = 0; m < 4; ++m)
#pragma unroll
                    for (int n = 0; n < 2; ++n) acc[a][b][m][n] = (f32x4){0.f, 0.f, 0.f, 0.f};
        cur = nxt; cA = nA; cB = nB; ++ui;
    }
    PG8_WAIT_V(0);
    if (wr == 0) PG8_BAR;
    PG8_BAR;
    return epi_ticks;
#undef PG8_SA
#undef PG8_SB
#undef PG8_STAGE
#undef PG8_LDA
#undef PG8_LDB
#undef PG8_MMA
#undef PG8_WAIT_V
#undef PG8_WAIT_L
#undef PG8_BAR
#undef PG8_SCHED
}
}

struct EpiP {
    static constexpr bool MIDK = false;
    static constexpr bool PERM = true;
    bf16_t* P; const float* rowsq;
    __device__ __forceinline__ void operator()(const f32x4 (&acc)[2][2][4][2], const pg8::Unit& u, int wr, int wc, int fr, int fq) const {
        const int row0 = u.pm * 256 + wr * 64 + fr, col0 = u.pn * 256 + wc * 32 + 8 * fq;
        if (u.pn >= 12 && u.pn < 20) {
            bf16_t* pp = P + (size_t)row0 * DIN + 3072 + (u.pn - 12) * 128 + wc * 32 + 8 * fq;
#pragma unroll
            for (int ai = 0; ai < 2; ++ai)
#pragma unroll
                for (int m = 0; m < 4; ++m) {
                    const float rs = row_rs4(rowsq, row0 + ai * 128 + m * 16, fq), rs2 = rs * rs;
                    const f32x4 q0 = acc[ai][0][m][0] * acc[ai][0][m][1] * rs2, q1 = acc[ai][1][m][0] * acc[ai][1][m][1] * rs2;
                    u32x4 w; w.x = cvt_pk_bf16(q0[0], q0[1]); w.y = cvt_pk_bf16(q0[2], q0[3]); w.z = cvt_pk_bf16(q1[0], q1[1]); w.w = cvt_pk_bf16(q1[2], q1[3]);
                    *(u32x4*)(pp + (size_t)(ai * 128 + m * 16) * DIN) = w;
                }
            return;
        }
#pragma unroll
        for (int ai = 0; ai < 2; ++ai) {
            f32x4 q0[4], q1[4];
#pragma unroll
            for (int m = 0; m < 4; ++m) { const f32x4* q = (const f32x4*)(rowsq + (size_t)(row0 + ai * 128 + m * 16) * 32) + 2 * fq; q0[m] = q[0]; q1[m] = q[1]; }
            __builtin_amdgcn_sched_barrier(0);
#pragma unroll
            for (int m = 0; m < 4; ++m) {
                const int row = row0 + ai * 128 + m * 16;
                const f32x4 sv = q0[m] + q1[m];
                float t = (sv[0] + sv[1]) + (sv[2] + sv[3]);
                t += __shfl_xor(t, 16); t += __shfl_xor(t, 32);
                const float rs = rsqrtf(t * (1.0f / D) + EPS);
                bf16_t* rowp = P + (size_t)row * DIN + col0;
#pragma unroll
                for (int bj = 0; bj < 2; ++bj) {
                    const f32x4 v0 = acc[ai][bj][m][0] * rs, v1 = acc[ai][bj][m][1] * rs;
                    u32x4 w; w.x = cvt_pk_bf16(v0[0], v0[1]); w.y = cvt_pk_bf16(v0[2], v0[3]); w.z = cvt_pk_bf16(v1[0], v1[1]); w.w = cvt_pk_bf16(v1[2], v1[3]);
                    *(u32x4*)(rowp + bj * 128) = w;
                }
            }
        }
    }
};
struct EpiM {
    static constexpr bool PERM = true, MIDK = true;
    bf16_t* P;
    __device__ __forceinline__ void mid(f32x4 (&acc)[2][2][4][2], const pg8::Unit& u, int wr, int wc, int fr, int fq) const {
        const int row0 = u.pm * 256 + wr * 64 + fr, col0 = u.pn * 256 + wc * 32 + 8 * fq;
        const bf16_t* gbase = P + (size_t)row0 * DIN + col0 + 5120;
#pragma unroll
        for (int ai = 0; ai < 2; ++ai)
#pragma unroll
            for (int mp = 0; mp < 2; ++mp) {
                u32x4 ga[2][2], gb[2][2];
#pragma unroll
                for (int mm = 0; mm < 2; ++mm) { const bf16_t* gp = gbase + (size_t)(ai * 128 + (mp * 2 + mm) * 16) * DIN;
#pragma unroll
                    for (int bj = 0; bj < 2; ++bj) { ga[mm][bj] = *(const u32x4*)(gp + bj * 128); gb[mm][bj] = *(const u32x4*)(gp + 1024 + bj * 128); } }
                __builtin_amdgcn_sched_barrier(0);
#pragma unroll
                for (int mm = 0; mm < 2; ++mm) {
                    const int m = mp * 2 + mm;
#pragma unroll
                    for (int bj = 0; bj < 2; ++bj) {
                        float fa[8], fb[8]; unpack8(ga[mm][bj], fa); unpack8(gb[mm][bj], fb);
                        f32x4 r0, r1;
#pragma unroll
                        for (int j = 0; j < 4; ++j) {
                            r0[j] = (1.0f + __builtin_amdgcn_exp2f(-1.4426950408889634f * fb[j])) * __builtin_amdgcn_rcpf(1.0f + __builtin_amdgcn_exp2f(-1.4426950408889634f * fa[j]));
                            r1[j] = (1.0f + __builtin_amdgcn_exp2f(-1.4426950408889634f * fb[4 + j])) * __builtin_amdgcn_rcpf(1.0f + __builtin_amdgcn_exp2f(-1.4426950408889634f * fa[4 + j]));
                        }
                        acc[ai][bj][m][0] *= r0; acc[ai][bj][m][1] *= r1;
                    }
                }
            }
    }
    __device__ __forceinline__ void operator()(const f32x4 (&acc)[2][2][4][2], const pg8::Unit& u, int wr, int wc, int fr, int fq) const {
        const int row0 = u.pm * 256 + wr * 64 + fr, col0 = u.pn * 256 + wc * 32 + 8 * fq;
#pragma unroll
        for (int ai = 0; ai < 2; ++ai)
#pragma unroll
            for (int mp = 0; mp < 2; ++mp) {
                u32x4 gw[2][2];
#pragma unroll
                for (int mm = 0; mm < 2; ++mm)
#pragma unroll
                    for (int bj = 0; bj < 2; ++bj) gw[mm][bj] = *(const u32x4*)(P + (size_t)(row0 + ai * 128 + (mp * 2 + mm) * 16) * DIN + col0 + 6144 + bj * 128);
                __builtin_amdgcn_sched_barrier(0);
#pragma unroll
                for (int mm = 0; mm < 2; ++mm) {
                    const int m = mp * 2 + mm;
                    const int row = row0 + ai * 128 + m * 16;
                    bf16_t* rowp = P + (size_t)row * DIN + col0;
#pragma unroll
                    for (int bj = 0; bj < 2; ++bj) {
                        float gf[8]; unpack8(gw[mm][bj], gf);
                        const f32x4 a0 = acc[ai][bj][m][0], a1 = acc[ai][bj][m][1];
                        float o[8];
#pragma unroll
                        for (int j = 0; j < 4; ++j) { o[j] = a0[j] * sigmoidf_(gf[j]); o[4 + j] = a1[j] * sigmoidf_(gf[4 + j]); }
                        *(u32x4*)(rowp + 3072 + bj * 128) = pack8(o);
                    }
                }
            }
    }
};
struct EpiRes {
    static constexpr bool MIDK = false;
    static constexpr bool PERM = true;
    float* X; bf16_t* XB; float* rowsq;
    __device__ __forceinline__ void operator()(const f32x4 (&acc)[2][2][4][2], const pg8::Unit& u, int wr, int wc, int fr, int fq) const {
        const int row0 = u.pm * 256 + wr * 64 + fr, col0 = u.pn * 256 + wc * 32 + 8 * fq;
#pragma unroll
        for (int ai = 0; ai < 2; ++ai)
#pragma unroll
            for (int mp = 0; mp < 2; ++mp) {
                u32x4 xv[2][2];
#pragma unroll
                for (int mm = 0; mm < 2; ++mm)
#pragma unroll
                    for (int bj = 0; bj < 2; ++bj) xv[mm][bj] = *(const u32x4*)(XB + (size_t)(row0 + ai * 128 + (mp * 2 + mm) * 16) * D + col0 + bj * 128);
                __builtin_amdgcn_sched_barrier(0);
#pragma unroll
                for (int mm = 0; mm < 2; ++mm) {
                    const int m = mp * 2 + mm;
                    const int row = row0 + ai * 128 + m * 16;
                    bf16_t* xbr = XB + (size_t)row * D + col0;
#pragma unroll
                    for (int bj = 0; bj < 2; ++bj) {
                        float xf[8]; unpack8(xv[mm][bj], xf);
                        float o[8]; float ss = 0.f;
#pragma unroll
                        for (int jj = 0; jj < 4; ++jj) { o[jj] = xf[jj] + acc[ai][bj][m][0][jj]; o[4 + jj] = xf[4 + jj] + acc[ai][bj][m][1][jj]; }
#pragma unroll
                        for (int jj = 0; jj < 8; ++jj) ss += o[jj] * o[jj];
                        *(u32x4*)(xbr + bj * 128) = pack8(o);
                        ss += __shfl_xor(ss, 16); ss += __shfl_xor(ss, 32);
                        if (fq == 0) rowsq[(size_t)row * 32 + u.pn * 8 + bj * 4 + wc] = ss;
                    }
                }
            }
    }
};
struct EpiGlu {
    static constexpr bool MIDK = false;
    static constexpr bool PERM = false;
    bf16_t* P; const float* rowsq;
    __device__ __forceinline__ void operator()(const f32x4 (&acc)[2][2][4][2], const pg8::Unit& u, int wr, int wc, int fr, int fq) const {
        const int row0 = u.pm * 256 + wr * 64 + fr, col0 = u.pn * 128 + wc * 16 + 4 * fq;
#pragma unroll
        for (int aih = 0; aih < 4; ++aih) {
            const int ai = aih >> 1;
            f32x4 q0[4], q1[4];
#pragma unroll
            for (int m = 0; m < 4; ++m) if ((m >> 1) == (aih & 1)) { const f32x4* q = (const f32x4*)(rowsq + (size_t)(row0 + ai * 128 + m * 16) * 32) + 2 * fq; q0[m] = q[0]; q1[m] = q[1]; }
            __builtin_amdgcn_sched_barrier(0);
#pragma unroll
            for (int m = 0; m < 4; ++m) if ((m >> 1) == (aih & 1)) {
                const int row = row0 + ai * 128 + m * 16;
                const f32x4 sv = q0[m] + q1[m];
                float t = (sv[0] + sv[1]) + (sv[2] + sv[3]);
                t += __shfl_xor(t, 16); t += __shfl_xor(t, 32);
                const float rs = rsqrtf(t * (1.0f / D) + EPS);
                bf16_t* rowp = P + (size_t)row * DIN + col0;
#pragma unroll
                for (int bj = 0; bj < 2; ++bj) {
                    const f32x4 gv = acc[ai][bj][m][0] * rs, uv = acc[ai][bj][m][1] * rs;
                    float o[4];
#pragma unroll
                    for (int j = 0; j < 4; ++j) o[j] = gv[j] * sigmoidf_(gv[j]) * uv[j];
                    u32x2 w; w.x = cvt_pk_bf16(o[0], o[1]); w.y = cvt_pk_bf16(o[2], o[3]);
                    *(u32x2*)(rowp + bj * 64) = w;
                }
            }
        }
    }
};

constexpr int XROW0 = SAMPLE_ROW0, XRB = 5, XTILES_M = 7;
struct MiniM {
    static constexpr bool AB = true;
    bf16_t* P;
    __device__ __forceinline__ void operator()(const f32x4 (&fa)[2], const f32x4 (&fb)[2], int row, int ct, int fq) const {
        bf16_t* rowp = P + (size_t)row * DIN + ct * 32 + 8 * fq;
        float ga[8], gb[8]; unpack8(*(const u32x4*)(rowp + 5120), ga); unpack8(*(const u32x4*)(rowp + 6144), gb);
        float o[8];
#pragma unroll
        for (int j = 0; j < 4; ++j) { o[j] = fa[0][j] * sigmoidf_(ga[j]) + fb[0][j] * sigmoidf_(gb[j]); o[4 + j] = fa[1][j] * sigmoidf_(ga[4 + j]) + fb[1][j] * sigmoidf_(gb[4 + j]); }
        *(u32x4*)(rowp + 3072) = pack8(o);
    }
};
struct MiniRes {
    static constexpr bool AB = false;
    float* X; bf16_t* XB; float* rowsq;
    __device__ __forceinline__ void operator()(const f32x4 (&acc)[2], const f32x4 (&)[2], int row, int ct, int fq) const {
        bf16_t* xbr = XB + (size_t)row * D + ct * 32 + 8 * fq;
        float xf[8]; unpack8(*(const u32x4*)xbr, xf);
        float o[8]; float ss = 0.f;
#pragma unroll
        for (int jj = 0; jj < 4; ++jj) { o[jj] = xf[jj] + acc[0][jj]; o[4 + jj] = xf[4 + jj] + acc[1][jj]; }
#pragma unroll
        for (int jj = 0; jj < 8; ++jj) ss += o[jj] * o[jj];
        *(u32x4*)xbr = pack8(o);
        ss += __shfl_xor(ss, 16); ss += __shfl_xor(ss, 32);
        if (fq == 0) rowsq[(size_t)row * 32 + ct] = ss;
    }
};
template <class Epi>
__device__ __forceinline__ void mini_phase(LAS unsigned char* lds, const bf16_t* A, int lda, int a_split_ct, int a_split_off, const bf16_t* Bt, int K, int nct, const Epi& E, int tid_in, int wg, int nwg) {
    int tid = tid_in; asm volatile("" : "+v"(tid));
    const int wid = __builtin_amdgcn_readfirstlane(tid >> 6), lane = tid & 63, fr = lane & 15, fq = lane >> 4;
    LAS f32x4* R = (LAS f32x4*)lds;
    const int kslice = K >> 3, nks = kslice >> 5;
    for (int tile = wg; tile < XTILES_M * nct; tile += nwg) {
        const int ct = tile / XTILES_M, rt = tile % XTILES_M;
        const int row0 = XROW0 + rt * (16 * XRB);
        const bf16_t* ap = A + (size_t)(row0 + fr) * lda + (ct >= a_split_ct ? a_split_off : 0) + wid * kslice + fq * 8;
        const bf16_t* bp = Bt + (size_t)(ct * 32 + fr) * K + wid * kslice + fq * 8;
        f32x4 acc[XRB][2];
#pragma unroll
        for (int rb = 0; rb < XRB; ++rb) { acc[rb][0] = (f32x4){0.f, 0.f, 0.f, 0.f}; acc[rb][1] = (f32x4){0.f, 0.f, 0.f, 0.f}; }
        bf16x8 a0[XRB], b0[2], a1[XRB], b1[2];
#define MINI_LOAD(a, b, ks) do { _Pragma("unroll") for (int rb = 0; rb < XRB; ++rb) a[rb] = *(const bf16x8*)(ap + (size_t)rb * 16 * lda + (ks) * 32); \
            b[0] = *(const bf16x8*)(bp + (ks) * 32); b[1] = *(const bf16x8*)(bp + (size_t)16 * K + (ks) * 32); } while (0)
#define MINI_MMA(a, b) do { _Pragma("unroll") for (int rb = 0; rb < XRB; ++rb) { \
            acc[rb][0] = __builtin_amdgcn_mfma_f32_16x16x32_bf16(b[0], a[rb], acc[rb][0], 0, 0, 0); \
            acc[rb][1] = __builtin_amdgcn_mfma_f32_16x16x32_bf16(b[1], a[rb], acc[rb][1], 0, 0, 0); } } while (0)
        MINI_LOAD(a0, b0, 0);
        for (int ks = 0; ks < nks; ks += 2) {
            if (ks + 1 < nks) MINI_LOAD(a1, b1, ks + 1);
            __builtin_amdgcn_sched_barrier(0);
            MINI_MMA(a0, b0);
            __builtin_amdgcn_sched_barrier(0);
            if (ks + 2 < nks) MINI_LOAD(a0, b0, ks + 2);
            __builtin_amdgcn_sched_barrier(0);
            if (ks + 1 < nks) MINI_MMA(a1, b1);
            __builtin_amdgcn_sched_barrier(0);
        }
#undef MINI_LOAD
#undef MINI_MMA
#pragma unroll
        for (int rb = 0; rb < XRB; ++rb) { R[((wid * XRB + rb) * 2 + 0) * 64 + lane] = acc[rb][0]; R[((wid * XRB + rb) * 2 + 1) * 64 + lane] = acc[rb][1]; }
        __syncthreads();
        if (wid < XRB) {
            f32x4 fin[2], finb[2];
            fin[0] = R[((0 * XRB + wid) * 2 + 0) * 64 + lane]; fin[1] = R[((0 * XRB + wid) * 2 + 1) * 64 + lane];
            finb[0] = R[((4 * XRB + wid) * 2 + 0) * 64 + lane]; finb[1] = R[((4 * XRB + wid) * 2 + 1) * 64 + lane];
#pragma unroll
            for (int w2 = 1; w2 < 4; ++w2) { fin[0] += R[((w2 * XRB + wid) * 2 + 0) * 64 + lane]; fin[1] += R[((w2 * XRB + wid) * 2 + 1) * 64 + lane];
                                             finb[0] += R[(((w2 + 4) * XRB + wid) * 2 + 0) * 64 + lane]; finb[1] += R[(((w2 + 4) * XRB + wid) * 2 + 1) * 64 + lane]; }
            if (!Epi::AB) { fin[0] += finb[0]; fin[1] += finb[1]; }
            E(fin, finb, row0 + wid * 16 + fr, ct, fq);
        }
        __syncthreads();
    }
}

template <int NB>
__device__ __forceinline__ void cvt_tile(const float* src, int sld, const float* scale, bf16_t* dst, size_t dld, int n0, int mode, int rowoff, bf16_t* dst2,
                                         LAS bf16_t* Tb, int tid) {
    constexpr int NC = 64 * NB, LD = NC + 4, SH = (NB == 4) ? 6 : 4, CM = (NB == 4) ? 63 : 15, NI = 2 * NB;
    LAS float* T = (LAS float*)Tb;
    f32x4 v[NI];
#pragma unroll
    for (int i = 0; i < NI; ++i) { const int item = tid + NT * i, kr = item >> SH, nc = (item & CM) * 4; v[i] = __builtin_nontemporal_load((const f32x4*)(src + (size_t)kr * sld + nc)); }
#pragma unroll
    for (int i = 0; i < NI; ++i) {
        const int item = tid + NT * i, kr = item >> SH, nc = (item & CM) * 4;
        const float s = scale ? scale[kr] : 1.0f;
        *(LAS f32x4*)(T + kr * LD + nc) = v[i] * s;
    }
    __syncthreads();
#pragma unroll
    for (int i = 0; i < NB; ++i) {
        const int item = tid + NT * i, n = item % NC, kc = item / NC;
        float f[8];
#pragma unroll
        for (int j = 0; j < 8; ++j) f[j] = T[(kc * 8 + j) * LD + n];
        const u32x4 w = pack8(f);
        const int ng = n0 + n;
        const int c32 = ng & 31;
        const int qch = ng - ((mode == 5) ? 4096 : 3072);
        const int row = (mode == 0) ? (ng + rowoff) : (mode == 3) ? ((ng & ~31) + 16 * ((c32 >> 2) & 1) + 4 * (c32 >> 3) + (c32 & 3) + rowoff)
                      : (mode >= 4) ? (3072 + 256 * (qch >> 7) + 128 * ((qch >> 2) & 1) + 32 * ((qch >> 5) & 3) + (mode == 5 ? 16 : 0) + 4 * ((qch >> 3) & 3) + (qch & 3))
                                                                 : ((ng >> 4) * 32 + (ng & 15) + (mode == 2 ? 16 : 0));
        *(u32x4*)(dst + (size_t)row * dld + kc * 8) = w;
        if (dst2) *(u32x4*)(dst2 + (size_t)row * dld + kc * 8) = w;
    }
    __syncthreads();
}

constexpr int CV_T0 = 16 * 28, CV_T1 = CV_T0 + 64, CV_T2 = CV_T1 + 64, CV_T3 = CV_T2 + 64, CV_T4 = CV_T3 + 16 * 11, CV_T5 = CV_T4 + 16 * 11, CV_T6 = CV_T5 + 44 * 4,
              CV_T7 = CV_T6 + 16, CV_T8 = CV_T7 + 16, CV_SPLIT = 880;
__device__ __forceinline__ void convert_layer(const Params& p, int l, bf16_t* wset, LAS unsigned char* lds, int tid_in, int wg, int nwg, int j0, int j1) {
    int tid = tid_in; asm volatile("" : "+v"(tid));
    bf16_t* W1 = wset; bf16_t* WAB = W1 + W1_E; bf16_t* WO2 = WAB + WAB_E; bf16_t* WGU = WO2 + WO2_E; bf16_t* WD = WGU + WGU_E; bf16_t* WG = WD + WD_E;
    LAS bf16_t* T = (LAS bf16_t*)lds;
    for (int j = j0 + wg; j < j1; j += nwg) {
        if (j < CV_T0) { const int kt = j / 28, ntl = j % 28;
            cvt_tile<4>(in_ptr(7) + (size_t)l * D * DIN + (size_t)kt * 64 * DIN + ntl * 256, DIN, in_ptr(6) + l * D + kt * 64, W1 + kt * 64, D, ntl * 256, (ntl >= 12 && ntl < 16) ? 4 : (ntl >= 16 && ntl < 20) ? 5 : 3, 0, nullptr, T, tid);
        } else if (j < CV_T3) { const int which = (j - CV_T0) / 64, jj = (j - CV_T0) % 64, kt = jj / 4, ntl = jj % 4;
            if (which < 2) cvt_tile<4>(in_ptr(which == 0 ? 15 : 17) + (size_t)l * D * D + (size_t)kt * 64 * D + ntl * 256, D, nullptr, WAB + which * 1024 + kt * 64, 2048, ntl * 256, 3, 0, nullptr, T, tid);
            else cvt_tile<4>(in_ptr(18) + (size_t)l * D * D + (size_t)kt * 64 * D + ntl * 256, D, nullptr, WO2 + kt * 64, D, ntl * 256, 3, 0, nullptr, T, tid);
        } else if (j < CV_T5) { const int which = (j - CV_T3) / 176, jj = (j - CV_T3) % 176, kt = jj / 11, ntl = jj % 11;
            cvt_tile<4>(in_ptr(which == 0 ? 20 : 21) + (size_t)l * D * DFF + (size_t)kt * 64 * DFF + ntl * 256, DFF, in_ptr(19) + l * D + kt * 64, WGU + kt * 64, D, ntl * 256, 1 + which, 0, nullptr, T, tid);
        } else if (j < CV_T6) { const int jj = j - CV_T5, kt = jj / 4, ntl = jj % 4;
            cvt_tile<4>(in_ptr(22) + (size_t)l * DFF * D + (size_t)kt * 64 * D + ntl * 256, D, nullptr, WD + kt * 64, DFF, ntl * 256, 3, 0, nullptr, T, tid);
        } else { const int which = (j - CV_T6) / 16, h = (j - CV_T6) % 16;
            cvt_tile<1>(in_ptr(which == 0 ? 10 : 12) + (size_t)l * 16 * 4096 + (size_t)h * 4096, 64, nullptr, WG, 64, 0, 0, h * 128 + which * 64, nullptr, T, tid);
        }
    }
}

constexpr int XC_LD = 136;
constexpr int HB_LD = 132;
constexpr int N_MIX_TILES = 8 + 32 * NSEQ * 8 + 8 * 8;

__device__ __forceinline__ float gelu_tanh(float x) {
    const float t = -2.3022082f * (x + 0.044715f * x * x * x);
    return x * __builtin_amdgcn_rcpf(1.0f + __builtin_amdgcn_exp2f(t));
}

__device__ __forceinline__ void mixer_phase(const Params& p, int l, LAS unsigned char* lds, int tid_in, int wg, int nwg) {
    int tid = tid_in; asm volatile("" : "+v"(tid));
    bf16_t* P = (bf16_t*)(p.ws + OFF_P);
    const bf16_t* WG = (const bf16_t*)(p.ws + OFF_W + (size_t)(l & 1) * WSET_BYTES) + (W1_E + WAB_E + WO2_E + WGU_E + WD_E);
    u64* agg = (u64*)(p.ws + OFF_AGG) + (size_t)l * NSLOT * D;
    LAS bf16_t* XC = (LAS bf16_t*)lds;
    LAS float* HB = (LAS float*)(lds + 64 * XC_LD * 2);
    const float* w4 = in_ptr(8) + (size_t)l * 4 * D; const float* b4 = in_ptr(9) + (size_t)l * D;
    const float* w3 = in_ptr(16) + (size_t)l * 3 * D;
    const float* st_h = in_ptr(2) + (size_t)l * NDEC * D; const float* st_rc = in_ptr(3) + (size_t)l * NDEC * 3 * D; const float* st_sc = in_ptr(4) + (size_t)l * NDEC * 2 * D;
    float* out = p.out;
    const int wid = tid >> 6, lane = tid & 63, fr = lane & 15, fq = lane >> 4;

    const bool hp_fixed = (nwg & 7) == 0;
    const int hp0 = wg & 7;
    LAS float* CW = (LAS float*)(lds + 64 * XC_LD * 2 + 64 * HB_LD * 4);
    const int hl = wid >> 2, cgi = wid & 3;
    const int chl = wid * 16 + fr;
    LAS bf16_t* GWL = (LAS bf16_t*)(lds + 64 * XC_LD * 2 + 64 * HB_LD * 4 + 8 * 128 * 4);
    LAS u32x4* GRL = (LAS u32x4*)(lds + 64 * XC_LD * 2 + 64 * HB_LD * 4 + 8 * 128 * 4 + 256 * 72 * 2);
    float bav = 0.f, bxv = 0.f, spv = 0.f;
#define LOAD_HEAD_CONSTS(hp_) do { \
        const int cb_ = (hp_) * 128, C_ = cb_ + chl; \
        bav = in_ptr(11)[l * D + C_]; bxv = in_ptr(13)[l * D + C_]; spv = log1pf(__expf(-in_ptr(14)[l * D + C_])); \
        for (int i_ = tid; i_ < 8 * 128; i_ += NT) { const int a_ = i_ >> 7, ch_ = i_ & 127; \
            CW[i_] = (a_ < 4) ? w4[a_ * D + cb_ + ch_] : (a_ == 4) ? b4[cb_ + ch_] : w3[(a_ - 5) * D + cb_ + ch_]; } \
        for (int i_ = tid; i_ < 256 * 8; i_ += NT) { const int r_ = i_ >> 3, kc_ = (i_ & 7) * 8; \
            *(LAS u32x4*)(GWL + r_ * 72 + kc_) = *(const u32x4*)(WG + ((size_t)((hp_) * 256 + r_)) * 64 + kc_); } \
        __syncthreads(); } while (0)
    if (hp_fixed) LOAD_HEAD_CONSTS(hp0);
#define MIX_DECODE(tile_, type_, row0_, hp_, chunk_, seq_, ntok_) do { chunk_ = 0; seq_ = 0; ntok_ = 64; \
        if ((tile_) < 8) { type_ = 0; hp_ = (tile_); row0_ = META_ROW0; ntok_ = 16; } \
        else if ((tile_) < 8 + 2048) { const int j_ = (tile_) - 8; type_ = 1; hp_ = j_ & 7; seq_ = (j_ >> 3) & 7; chunk_ = j_ >> 6; row0_ = seq_ * SEQ + chunk_ * 64; } \
        else { const int j_ = (tile_) - 8 - 2048; type_ = 2; hp_ = j_ & 7; chunk_ = j_ >> 3; row0_ = SAMPLE_ROW0 + chunk_ * 64; } } while (0)
    u32x4 xr_[5], pr_[4], bc_[2];
    int n_type = 0, n_row0 = 0, n_hp = 0, n_chunk = 0, n_seq = 0, n_ntok = 0;
    if (wg < N_MIX_TILES) {
        MIX_DECODE(wg, n_type, n_row0, n_hp, n_chunk, n_seq, n_ntok);
        const int type = n_type, row0 = n_row0, chunk = n_chunk, ntok = n_ntok, cbase = n_hp * 128;
        const int vec = tid & 15, t0 = tid >> 4, c = cbase + vec * 8;
            {
                const int tb = 2 * t0; const bool valid = tb < ntok;
#pragma unroll
                for (int j = 0; j < 5; ++j) {
                    const int d = ((type == 2) ? (tb & 3) : tb) - 3 + j;
                    int row = row0 + tb - 3 + j;
                    if (d < 0) row = (type == 0) ? (MPAD - 1) : ((chunk > 0) ? row : (META_ROW0 + NMETA + d));
                    if (!valid) row = MPAD - 1;
                    if (type == 2 && d < 0) {
                        const int b = chunk * 16 + (tb >> 2);
                        const float* sp = st_rc + ((size_t)b * 3 + (d + 3)) * D + c;
                        const f32x4 s0 = *(const f32x4*)sp, s1 = *(const f32x4*)(sp + 4);
                        xr_[j] = (u32x4){cvt_pk_bf16(s0[0], s0[1]), cvt_pk_bf16(s0[2], s0[3]), cvt_pk_bf16(s1[0], s1[1]), cvt_pk_bf16(s1[2], s1[3])};
                        if (j >= 1) {
                            const float* sq = st_sc + ((size_t)b * 2 + (d + 2)) * D + c;
                            const f32x4 q0 = *(const f32x4*)sq, q1 = *(const f32x4*)(sq + 4);
                            pr_[j - 1] = (u32x4){cvt_pk_bf16(q0[0], q0[1]), cvt_pk_bf16(q0[2], q0[3]), cvt_pk_bf16(q1[0], q1[1]), cvt_pk_bf16(q1[2], q1[3])};
                        }
                    } else {
                        const bf16_t* rp = P + (size_t)row * DIN + c;
                        xr_[j] = *(const u32x4*)rp;
                        if (j >= 1) pr_[j - 1] = *(const u32x4*)(rp + 3072);
                        if (j >= 3) bc_[j - 3] = *(const u32x4*)(rp + 2048);
                    }
                }
            }
    }
    for (int tile = wg; tile < N_MIX_TILES; tile += nwg) {
        const int type = n_type, row0 = n_row0, hp = n_hp, chunk = n_chunk, seq = n_seq, ntok = n_ntok;
        const int cbase = hp * 128;
        if (!hp_fixed) { __syncthreads(); LOAD_HEAD_CONSTS(hp); }
        const int C = cbase + chl;
        {
            const int vec = tid & 15, t0 = tid >> 4, c = cbase + vec * 8;
            float xcA[2][8], vaccA[2][8];
            { const f32x4 b0 = *(const LAS f32x4*)(CW + 4 * 128 + vec * 8), b1 = *(const LAS f32x4*)(CW + 4 * 128 + vec * 8 + 4);
#pragma unroll
              for (int i = 0; i < 2; ++i)
#pragma unroll
                for (int j = 0; j < 4; ++j) { xcA[i][j] = b0[j]; xcA[i][4 + j] = b1[j]; vaccA[i][j] = 0.f; vaccA[i][4 + j] = 0.f; } }
#pragma unroll
            for (int k = 0; k < 4; ++k) {
                const f32x4 wa = *(const LAS f32x4*)(CW + k * 128 + vec * 8), wb = *(const LAS f32x4*)(CW + k * 128 + vec * 8 + 4);
#pragma unroll
                for (int i = 0; i < 2; ++i) {
                    float xv[8]; unpack8(xr_[i + k], xv);
#pragma unroll
                    for (int j = 0; j < 4; ++j) { xcA[i][j] += wa[j] * xv[j]; xcA[i][4 + j] += wb[j] * xv[4 + j]; }
                }
            }
#pragma unroll
            for (int k = 0; k < 3; ++k) {
                const f32x4 wa = *(const LAS f32x4*)(CW + (5 + k) * 128 + vec * 8), wb = *(const LAS f32x4*)(CW + (5 + k) * 128 + vec * 8 + 4);
#pragma unroll
                for (int i = 0; i < 2; ++i) {
                    float pv[8]; unpack8(pr_[i + k], pv);
#pragma unroll
                    for (int j = 0; j < 4; ++j) { vaccA[i][j] += wa[j] * pv[j]; vaccA[i][4 + j] += wb[j] * pv[4 + j]; }
                }
            }
#pragma unroll
            for (int i = 0; i < 2; ++i) {
                const int t = 2 * t0 + i; const bool valid = t < ntok;
                float (&xc)[8] = xcA[i]; float (&vacc)[8] = vaccA[i];
                if (valid) {
                    *(LAS u32x4*)(XC + t * XC_LD + vec * 8) = pack8(xc);
                    float bv[8]; unpack8(bc_[i], bv);
#pragma unroll
                    for (int j = 0; j < 8; ++j) bv[j] *= vacc[j];
                    *(u32x4*)(P + (size_t)(row0 + t) * DIN + 2048 + c) = pack8(bv);
                    int jr = -1; float* orc = nullptr; float* osc = nullptr;
                    if (type == 1 && chunk == 31) { jr = t - 61; orc = out + O_RCP + ((size_t)l * NSEQ + seq) * 3 * D; osc = out + O_SCP + ((size_t)l * NSEQ + seq) * 2 * D; }
                    else if (type == 2) { const int b = chunk * 16 + (t >> 2); jr = (t & 3) - 1; orc = out + O_RCS + ((size_t)l * NDEC + b) * 3 * D; osc = out + O_SCS + ((size_t)l * NDEC + b) * 2 * D; }
                    if (jr >= 0) { float xcur[8]; unpack8(xr_[3 + i], xcur);
                        float* o = orc + (size_t)jr * D + c;
                        *(f32x4*)o = (f32x4){xcur[0], xcur[1], xcur[2], xcur[3]}; *(f32x4*)(o + 4) = (f32x4){xcur[4], xcur[5], xcur[6], xcur[7]}; }
                    if (jr >= 1) { float pv[8]; unpack8(pr_[2 + i], pv);
                        float* o = osc + (size_t)(jr - 1) * D + c;
                        *(f32x4*)o = (f32x4){pv[0], pv[1], pv[2], pv[3]}; *(f32x4*)(o + 4) = (f32x4){pv[4], pv[5], pv[6], pv[7]}; }
                } else {
                    *(LAS u32x4*)(XC + t * XC_LD + vec * 8) = (u32x4){0u, 0u, 0u, 0u};
                }
            }
        }
        u32x4 gw[2];
        { const int vec = tid & 15, t0 = tid >> 4, c = cbase + vec * 8;
#pragma unroll
          for (int i = 0; i < 2; ++i) { const int t = 2 * t0 + i; gw[i] = *(const u32x4*)(P + (size_t)((t < ntok) ? (row0 + t) : (MPAD - 1)) * DIN + 1024 + c); } }
        __syncthreads();

        {
            bf16x8 Bf[2][2];
#pragma unroll
            for (int g = 0; g < 2; ++g)
#pragma unroll
                for (int ks = 0; ks < 2; ++ks) Bf[g][ks] = *(const LAS bf16x8*)(GWL + (hl * 128 + g * 64 + cgi * 16 + fr) * 72 + ks * 32 + fq * 8);
            const int nmt = (type == 0) ? 1 : 4;
            float Pl[4][4], Hl[4][4];
            float cP = 1.f, cH = 0.f;
#pragma unroll
            for (int mt = 0; mt < 4; ++mt) {
                if (mt < nmt) {
                    f32x4 ar = (f32x4){0.f, 0.f, 0.f, 0.f}, ai = (f32x4){0.f, 0.f, 0.f, 0.f};
#pragma unroll
                    for (int ks = 0; ks < 2; ++ks) {
                        const bf16x8 Af = *(const LAS bf16x8*)(XC + (mt * 16 + fr) * XC_LD + hl * 64 + ks * 32 + fq * 8);
                        ar = __builtin_amdgcn_mfma_f32_16x16x32_bf16(Af, Bf[0][ks], ar, 0, 0, 0);
                        ai = __builtin_amdgcn_mfma_f32_16x16x32_bf16(Af, Bf[1][ks], ai, 0, 0, 0);
                    }
                    float av[4], uv[4];
#pragma unroll
                    for (int r = 0; r < 4; ++r) {
                        const float rg = sigmoidf_(ar[r] + bav), ig = sigmoidf_(ai[r] + bxv);
                        const float la = -8.0f * rg * spv;
                        const float x2 = 2.0f * la;
                        const float em = (x2 > -0.05f) ? -x2 * (1.0f + x2 * (0.5f + x2 * (0.16666667f + x2 * 0.041666667f))) : 1.0f - __builtin_amdgcn_exp2f(1.4426950408889634f * x2);
                        av[r] = __builtin_amdgcn_exp2f(1.4426950408889634f * la);
                        const float xcv = bf2f(XC[(mt * 16 + fq * 4 + r) * XC_LD + chl]);
                        uv[r] = __builtin_amdgcn_sqrtf(fmaxf(em, 1e-12f)) * ig * xcv;
                    }
                    if (type == 2) {
                        const int b = chunk * 16 + mt * 4 + fq;
                        float h = st_h[(size_t)b * D + C];
#pragma unroll
                        for (int r = 0; r < 4; ++r) { h = av[r] * h + uv[r]; Hl[mt][r] = h; Pl[mt][r] = 0.f; }
                        out[O_HS + ((size_t)l * NDEC + b) * D + C] = h;
                    } else {
                        float pp[4], hh[4];
                        pp[0] = av[0]; hh[0] = uv[0];
#pragma unroll
                        for (int r = 1; r < 4; ++r) { pp[r] = pp[r - 1] * av[r]; hh[r] = av[r] * hh[r - 1] + uv[r]; }
                        float ap = pp[3], ah = hh[3];
                        float tp = __shfl_up(ap, 16), th = __shfl_up(ah, 16);
                        if (fq >= 1) { ah = ap * th + ah; ap = ap * tp; }
                        tp = __shfl_up(ap, 32); th = __shfl_up(ah, 32);
                        if (fq >= 2) { ah = ap * th + ah; ap = ap * tp; }
                        float ep = __shfl_up(ap, 16), eh = __shfl_up(ah, 16);
                        if (fq == 0) { ep = 1.f; eh = 0.f; }
                        const float bp = cP * ep, bh = ep * cH + eh;
#pragma unroll
                        for (int r = 0; r < 4; ++r) { Pl[mt][r] = bp * pp[r]; Hl[mt][r] = pp[r] * bh + hh[r]; }
                        tp = __shfl(ap, 48 + fr); th = __shfl(ah, 48 + fr);
                        cH = tp * cH + th; cP = cP * tp;
                    }
                } else {
#pragma unroll
                    for (int r = 0; r < 4; ++r) { Pl[mt][r] = 0.f; Hl[mt][r] = 0.f; }
                }
            }
            if (type != 2) {
                const int slot = (type == 0) ? 0 : (1 + seq * 32 + chunk);
                if (fq == 0) __hip_atomic_store(agg + (size_t)slot * D + C, ((u64)__float_as_uint(cH) << 32) | (u64)__float_as_uint(cP), __ATOMIC_RELAXED, __HIP_MEMORY_SCOPE_AGENT);
                float carry = 0.f;
                if (type == 1) {
                    const int npred = chunk + 1, cnt = (npred + 3) >> 2, jb = fq * cnt;
                    u64 v[8];
                    unsigned spins = 0;
                    for (;;) {
                        bool ok = true;
#pragma unroll
                        for (int i = 0; i < 8; ++i) {
                            const int j = jb + i;
                            if (i < cnt && j < npred) {
                                const int sl = (j == 0) ? 0 : (seq * 32 + j);
                                v[i] = __hip_atomic_load(agg + (size_t)sl * D + C, __ATOMIC_RELAXED, __HIP_MEMORY_SCOPE_AGENT);
                                ok = ok && ((unsigned)v[i] != 0xFFFFFFFFu);
                            } else v[i] = 0ull;
                        }
                        if (__all(ok)) break;
                        if (++spins > 200000u) break;
                        __builtin_amdgcn_s_sleep(2);
                    }
                    float Ag = 1.f, Hg = 0.f;
#pragma unroll
                    for (int i = 0; i < 8; ++i) {
                        const int j = jb + i;
                        if (i < cnt && j < npred) { const float A = __uint_as_float((unsigned)v[i]), H = __uint_as_float((unsigned)(v[i] >> 32)); Hg = A * Hg + H; Ag = A * Ag; }
                    }
#pragma unroll
                    for (int q = 0; q < 4; ++q) { const float Aq = __shfl(Ag, q * 16 + fr), Hq = __shfl(Hg, q * 16 + fr); carry = Aq * carry + Hq; }
                }
#pragma unroll
                for (int mt = 0; mt < 4; ++mt)
#pragma unroll
                    for (int r = 0; r < 4; ++r) Hl[mt][r] = Hl[mt][r] + Pl[mt][r] * carry;
                if (type == 1 && chunk == 31 && fq == 3) out[O_HP + ((size_t)l * NSEQ + seq) * D + C] = Hl[3][3];
            }
        if (tile + nwg < N_MIX_TILES) {
            MIX_DECODE(tile + nwg, n_type, n_row0, n_hp, n_chunk, n_seq, n_ntok);
            const int type = n_type, row0 = n_row0, chunk = n_chunk, ntok = n_ntok, cbase = n_hp * 128;
            const int vec = tid & 15, t0 = tid >> 4, c = cbase + vec * 8;
            {
                const int tb = 2 * t0; const bool valid = tb < ntok;
#pragma unroll
                for (int j = 0; j < 5; ++j) {
                    const int d = ((type == 2) ? (tb & 3) : tb) - 3 + j;
                    int row = row0 + tb - 3 + j;
                    if (d < 0) row = (type == 0) ? (MPAD - 1) : ((chunk > 0) ? row : (META_ROW0 + NMETA + d));
                    if (!valid) row = MPAD - 1;
                    if (type == 2 && d < 0) {
                        const int b = chunk * 16 + (tb >> 2);
                        const float* sp = st_rc + ((size_t)b * 3 + (d + 3)) * D + c;
                        const f32x4 s0 = *(const f32x4*)sp, s1 = *(const f32x4*)(sp + 4);
                        xr_[j] = (u32x4){cvt_pk_bf16(s0[0], s0[1]), cvt_pk_bf16(s0[2], s0[3]), cvt_pk_bf16(s1[0], s1[1]), cvt_pk_bf16(s1[2], s1[3])};
                        if (j >= 1) {
                            const float* sq = st_sc + ((size_t)b * 2 + (d + 2)) * D + c;
                            const f32x4 q0 = *(const f32x4*)sq, q1 = *(const f32x4*)(sq + 4);
                            pr_[j - 1] = (u32x4){cvt_pk_bf16(q0[0], q0[1]), cvt_pk_bf16(q0[2], q0[3]), cvt_pk_bf16(q1[0], q1[1]), cvt_pk_bf16(q1[2], q1[3])};
                        }
                    } else {
                        const bf16_t* rp = P + (size_t)row * DIN + c;
                        xr_[j] = *(const u32x4*)rp;
                        if (j >= 1) pr_[j - 1] = *(const u32x4*)(rp + 3072);
                        if (j >= 3) bc_[j - 3] = *(const u32x4*)(rp + 2048);
                    }
                }
            }
        }
#pragma unroll
            for (int mt = 0; mt < 4; ++mt)
#pragma unroll
                for (int r = 0; r < 4; ++r) HB[(mt * 16 + fq * 4 + r) * HB_LD + chl] = Hl[mt][r];
        }
        __syncthreads();

        {
            const int vec = tid & 15, t0 = tid >> 4, c = cbase + vec * 8;
#pragma unroll
            for (int i = 0; i < 2; ++i) {
                const int t = 2 * t0 + i;
                if (t < ntok) {
                    float gv[8]; unpack8(gw[i], gv);
                    const f32x4 h0 = *(const LAS f32x4*)(HB + t * HB_LD + vec * 8), h1 = *(const LAS f32x4*)(HB + t * HB_LD + vec * 8 + 4);
                    float o[8];
#pragma unroll
                    for (int j = 0; j < 4; ++j) { o[j] = h0[j] * gelu_tanh(gv[j]); o[4 + j] = h1[j] * gelu_tanh(gv[4 + j]); }
                    *(u32x4*)(P + (size_t)(row0 + t) * DIN + 1024 + c) = pack8(o);
                }
            }
        }
    }
    __syncthreads();
}


#define XB_TMO      128
#define XB_XCNT(j)  (256  + 64 * (j))
#define XB_XSUB(j)  (1280 + 64 * (j))
#define XB_XGEN(j)  (2304 + 64 * (j))
#define XB_TOP      3328
#define XB_TOPGEN   3392
#define XCD_BAR_WORDS 3456
#define XB_SPIN_CAP (1u << 20)
__device__ __forceinline__ unsigned xb_ld(unsigned* p)              { return __hip_atomic_load(p, __ATOMIC_RELAXED, __HIP_MEMORY_SCOPE_AGENT); }
__device__ __forceinline__ unsigned xb_add(unsigned* p, unsigned v) { return __hip_atomic_fetch_add(p, v, __ATOMIC_RELAXED, __HIP_MEMORY_SCOPE_AGENT); }
__device__ __forceinline__ unsigned xb_xcc_id() { return (unsigned)__builtin_amdgcn_s_getreg((3 << 11) | 20) & 0xFu; }
#define XB_SPIN(cond, bar) do { unsigned _sp = 0; while (cond) { __builtin_amdgcn_s_sleep(1); \
    if ((++_sp & 255u) == 0u) { if (xb_ld(&(bar)[XB_TMO])) break; if (_sp > XB_SPIN_CAP) { atomicAdd(&(bar)[XB_TMO], 1u); break; } } } } while (0)
struct XcdBarrier { unsigned* bar; unsigned x; volatile LAS unsigned* st; };
__device__ __forceinline__ XcdBarrier xcd_barrier_post(unsigned* bar, volatile LAS unsigned* st) {
    XcdBarrier b; b.bar = bar; b.x = xb_xcc_id(); b.st = st;
    if (threadIdx.x == 0) (void)xb_add(&bar[XB_XCNT(b.x)], 1u);
    return b;
}
__device__ __forceinline__ void xcd_barrier_complete(unsigned* bar, unsigned x, unsigned& nloc, unsigned& nx) {
    const unsigned G = gridDim.x * gridDim.y * gridDim.z;
    unsigned sum, cnt, mine, sp = 0u;
    for (;;) {
        sum = 0u; cnt = 0u; mine = 0u;
#pragma unroll
        for (unsigned j = 0; j < 16; ++j) { const unsigned c = xb_ld(&bar[XB_XCNT(j)]); sum += c; cnt += (c > 0u) ? 1u : 0u; mine = (j == x) ? c : mine; }
        if (sum == G) break;
        __builtin_amdgcn_s_sleep(1);
        if ((++sp & 255u) == 0u) { if (xb_ld(&bar[XB_TMO])) break; if (sp > XB_SPIN_CAP) { atomicAdd(&bar[XB_TMO], 1u); break; } }
    }
    nloc = mine > 0u ? mine : 1u; nx = cnt > 0u ? cnt : 1u;
}
__device__ __forceinline__ void xcd_barrier(const XcdBarrier& b) {
    asm volatile("s_waitcnt vmcnt(0)" ::: "memory");
    __syncthreads();
    if (threadIdx.x == 0) {
        unsigned* bar = b.bar;
        __builtin_amdgcn_s_waitcnt(0);
        unsigned nloc = b.st[0], nx = b.st[1];
        if (nloc == 0u) { xcd_barrier_complete(bar, b.x, nloc, nx); b.st[0] = nloc; b.st[1] = nx; }
        const unsigned old = xb_add(&bar[XB_XSUB(b.x)], 1u);
        const unsigned gen = old / nloc;
        if (old + 1u == (gen + 1u) * nloc) {
            __builtin_amdgcn_fence(__ATOMIC_RELEASE, "agent");
            asm volatile("s_waitcnt vmcnt(0)" ::: "memory");
            const unsigned og = xb_add(&bar[XB_TOP], 1u);
            const unsigned tg = og / nx;
            if (og + 1u == (tg + 1u) * nx) xb_add(&bar[XB_TOPGEN], 1u);
            else XB_SPIN(xb_ld(&bar[XB_TOPGEN]) == tg, bar);
            __builtin_amdgcn_fence(__ATOMIC_ACQUIRE, "agent");
            xb_add(&bar[XB_XGEN(b.x)], 1u);
            asm volatile("s_waitcnt vmcnt(0)" ::: "memory");
        } else {
            XB_SPIN(xb_ld(&bar[XB_XGEN(b.x)]) == gen, bar);
            __builtin_amdgcn_fence(__ATOMIC_ACQUIRE, "agent");
            asm volatile("s_waitcnt vmcnt(0)" ::: "memory");
        }
    }
    __syncthreads();
}

__global__ void __launch_bounds__(NT, 2) fwd_megakernel(Params p) {
    extern __shared__ __attribute__((aligned(16))) unsigned char lds_raw[];
    LAS unsigned char* lds = (LAS unsigned char*)lds_raw;
    cg::grid_group grid = cg::this_grid();
    const int tid = threadIdx.x, wg = blockIdx.x, nwg = gridDim.x;
#ifdef PROBE_MODE
    unsigned long long tacc = 0, tmark = 0;
#define PB_BEGIN(k) do { if (PROBE_MODE == (k)) tmark = __builtin_amdgcn_s_memrealtime(); } while (0)
#define PB_END(k) do { if (PROBE_MODE == (k)) tacc += __builtin_amdgcn_s_memrealtime() - tmark; } while (0)
#define PB_ADD(k, v) do { if (PROBE_MODE == (k)) tacc += (v); } while (0)
#else
#define PB_ADD(k, v) do { (void)(v); } while (0)
#define PB_BEGIN(k) do {} while (0)
#define PB_END(k) do {} while (0)
#endif
#define GSYNC() do { PB_BEGIN(2); xcd_barrier(xbar); PB_END(2); } while (0)
    unsigned char* ws = p.ws;
    bf16_t* P = (bf16_t*)(ws + OFF_P);
    float* X = (float*)(ws + OFF_X);
    bf16_t* XB = (bf16_t*)(ws + OFF_XB);
    float* RS1 = (float*)(ws + OFF_RS1);
    float* RS2 = (float*)(ws + OFF_RS2);

    volatile LAS unsigned* bst = (volatile LAS unsigned*)(lds + 128 * 1024);
    if (tid < 4) bst[tid] = 0u;
    __syncthreads();
    const XcdBarrier xbar = xcd_barrier_post((unsigned*)(ws + OFF_BAR), bst);
#ifndef NO_CVT
    convert_layer(p, 0, (bf16_t*)(ws + OFF_W), lds, tid, wg, nwg, 0, CV_T8);
#endif
    { int tid0 = threadIdx.x; asm volatile("" : "+v"(tid0)); const int wid = tid0 >> 6, lane = tid0 & 63;
    for (int row = wg * 8 + wid; row < MPAD; row += nwg * 8) {
        const float* src = nullptr;
        if (row < SAMPLE_ROW0) src = in_ptr(0) + (size_t)row * D;
        else if (row < META_ROW0) src = in_ptr(1) + (size_t)(row - SAMPLE_ROW0) * D;
        else if (row < META_ROW0 + NMETA) src = in_ptr(5) + (size_t)(row - META_ROW0) * D;
        float ss = 0.f;
#pragma unroll
        for (int i = 0; i < 4; ++i) {
            const int c = i * 256 + lane * 4;
            f32x4 v = (f32x4){0.f, 0.f, 0.f, 0.f};
            if (src) v = *(const f32x4*)(src + c);
            u32x2 w; w.x = cvt_pk_bf16(v[0], v[1]); w.y = cvt_pk_bf16(v[2], v[3]);
            *(u32x2*)(XB + (size_t)row * D + c) = w;
            ss += (v[0] * v[0] + v[1] * v[1]) + (v[2] * v[2] + v[3] * v[3]);
        }
#pragma unroll
        for (int o = 32; o >= 1; o >>= 1) ss += __shfl_xor(ss, o);
        if (lane < 32) RS1[(size_t)row * 32 + lane] = (lane == 0) ? ss : 0.f;
    }
    }
    {
        u32x4* a = (u32x4*)(ws + OFF_AGG);
        const size_t n16 = AGG_BYTES / 16;
        for (size_t i = (size_t)wg * NT + tid; i < n16; i += (size_t)nwg * NT) a[i] = (u32x4){0xFFFFFFFFu, 0xFFFFFFFFu, 0xFFFFFFFFu, 0xFFFFFFFFu};
    }
    grid.sync();

    for (int l = 0; l < DEPTH; ++l) {
        const bf16_t* wset = (const bf16_t*)(ws + OFF_W + (size_t)(l & 1) * WSET_BYTES);
        const bf16_t* W1 = wset; const bf16_t* WAB = W1 + W1_E; const bf16_t* WO2 = WAB + WAB_E; const bf16_t* WGU = WO2 + WO2_E; const bf16_t* WD = WGU + WGU_E;
        {
            pg8::Gemm g{XB, W1, MPAD, DIN, D, D, 1 << 30, 0}; pg8::StaticOrder S; S.init(MPAD, DIN, nwg, wg);
            EpiP E{P, RS1};
            PB_BEGIN(4);
            { const unsigned long long et_ = pg8::gemm_phase<EpiP>(lds, g, S, E); PB_ADD(6, et_); }
            PB_END(4);
            { const int nlast = (MPAD / 256) * (DIN / 256) - 7 * nwg;
              const bool part = nlast > 0 && nlast < nwg;
              const int cw = part ? wg - nlast : wg, cn = part ? nwg - nlast : nwg;
              if (l + 1 < DEPTH && cw >= 0) convert_layer(p, l + 1, (bf16_t*)(ws + OFF_W + (size_t)((l + 1) & 1) * WSET_BYTES), lds, tid, cw, cn, 0, part ? CV_SPLIT : CV_T8); }
        }
        GSYNC();
        PB_BEGIN(1); PB_BEGIN(3);
        PB_END(3);
#ifndef NO_MIXER
        mixer_phase(p, l, lds, tid, wg, nwg);
#endif
        PB_END(1);
        GSYNC();
        {
            pg8::Gemm g{P + 1024, WAB, SAMPLE_ROW0, D, 2048, DIN, 1 << 30, 0}; pg8::StaticOrder S; S.init(SAMPLE_ROW0, D, nwg, wg);
            EpiM E{P};
            { const unsigned long long et_ = pg8::gemm_phase<EpiM>(lds, g, S, E); PB_ADD(6, et_); }
            MiniM EM{P};
            mini_phase<MiniM>(lds, P + 1024, DIN, 1 << 30, 0, WAB, 2048, 32, EM, tid, wg, nwg);
        }
        GSYNC();
        {
            pg8::Gemm g{P + 3072, WO2, SAMPLE_ROW0, D, D, DIN, 1 << 30, 0}; pg8::StaticOrder S; S.init(SAMPLE_ROW0, D, nwg, wg);
            EpiRes E{X, XB, RS2};
            { const unsigned long long et_ = pg8::gemm_phase<EpiRes>(lds, g, S, E); PB_ADD(6, et_); }
            MiniRes EM{X, XB, RS2};
            mini_phase<MiniRes>(lds, P + 3072, DIN, 1 << 30, 0, WO2, D, 32, EM, tid, wg, nwg);
        }
        GSYNC();
        {
            pg8::Gemm g{XB, WGU, MPAD, 2 * DFF, D, D, 1 << 30, 0}; pg8::StaticOrder S; S.init(MPAD, 2 * DFF, nwg, wg);
            EpiGlu E{P, RS2};
#if !defined(ONLY) || ONLY==4
            { const unsigned long long et_ = pg8::gemm_phase<EpiGlu>(lds, g, S, E); PB_ADD(6, et_); }
            { const int nu5 = (MPAD / 256) * (2 * DFF / 256), nlast5 = nu5 - (nu5 / nwg) * nwg, nlast1 = (MPAD / 256) * (DIN / 256) - 7 * nwg;
              const bool part1 = nlast1 > 0 && nlast1 < nwg;
              const bool part5 = nlast5 > 0 && nlast5 < nwg;
              const int cw = part5 ? wg - nlast5 : wg, cn = part5 ? nwg - nlast5 : nwg;
              if (l + 1 < DEPTH && part1 && cw >= 0) convert_layer(p, l + 1, (bf16_t*)(ws + OFF_W + (size_t)((l + 1) & 1) * WSET_BYTES), lds, tid, cw, cn, CV_SPLIT, CV_T8); }
#endif
        }
        GSYNC();
        {
            pg8::Gemm g{P, WD, SAMPLE_ROW0, D, DFF, DIN, 1 << 30, 0}; pg8::StaticOrder S; S.init(SAMPLE_ROW0, D, nwg, wg);
            EpiRes E{X, XB, RS1};
            PB_BEGIN(5);
            { const unsigned long long et_ = pg8::gemm_phase<EpiRes>(lds, g, S, E); PB_ADD(6, et_); }
            MiniRes EM{X, XB, RS1};
            mini_phase<MiniRes>(lds, P, DIN, 1 << 30, 0, WD, DFF, 32, EM, tid, wg, nwg);
            PB_END(5);
        }
        GSYNC();
    }

    {
        int tidf = threadIdx.x; asm volatile("" : "+v"(tidf));
        const int wid = tidf >> 6, lane = tidf & 63;
        const float* gfin = in_ptr(23);
        for (int row = (int)blockIdx.x * 8 + wid; row < MOUT; row += (int)gridDim.x * 8) {
            const float rs = row_rs(RS1, row);
#pragma unroll
            for (int i = 0; i < 4; ++i) {
                const int c = i * 256 + lane * 4;
                const u32x2 xw = *(const u32x2*)(XB + (size_t)row * D + c);
                const f32x4 v = (f32x4){bf_lo(xw.x), bf_hi(xw.x), bf_lo(xw.y), bf_hi(xw.y)}, gg = *(const f32x4*)(gfin + c);
                *(f32x4*)(p.out + O_Y + (size_t)row * D + c) = v * rs * gg;
            }
        }
    }
#ifdef PROBE_MODE
    if (wg == 0 && tid == 0) { const unsigned long long t0 = __builtin_amdgcn_s_memrealtime(); while (__builtin_amdgcn_s_memrealtime() - t0 < tacc) __builtin_amdgcn_s_sleep(8); }
#endif
}

extern "C" void kernel_launch(void* const* d_in, const int* in_sizes, int n_in, void* d_out, int out_size, void* d_ws, size_t ws_size, hipStream_t stream) {
    static int gridn = 0;
    if (!gridn) {
        int dev = 0, cus = 0, per_cu = 0;
        (void)hipGetDevice(&dev);
        (void)hipDeviceGetAttribute(&cus, hipDeviceAttributeMultiprocessorCount, dev);
        (void)hipFuncSetAttribute((const void*)fwd_megakernel, hipFuncAttributeMaxDynamicSharedMemorySize, LDS_BYTES);
        (void)hipOccupancyMaxActiveBlocksPerMultiprocessor(&per_cu, (const void*)fwd_megakernel, NT, LDS_BYTES);
        if (per_cu < 1) { fprintf(stderr, "kernel_launch: occupancy query says %d blocks per CU\n", per_cu); per_cu = 1; }
        gridn = cus;
        if (ws_size < WS_NEED) fprintf(stderr, "kernel_launch: workspace too small: %zu < %zu\n", ws_size, (size_t)WS_NEED);
    }
    if (ws_size < WS_NEED || n_in != 24) return;
    Params p{};
    for (int i = 0; i < 24; ++i) p.in[i] = (const float*)d_in[i];
    p.out = (float*)d_out; p.ws = (unsigned char*)d_ws;
    (void)hipMemsetAsync((unsigned char*)d_ws + OFF_BAR, 0, 16384, stream);
    void* args[] = {&p};
    hipError_t e = hipLaunchCooperativeKernel((const void*)fwd_megakernel, dim3(gridn), dim3(NT), args, LDS_BYTES, stream);
    if (e != hipSuccess) fprintf(stderr, "kernel_launch: cooperative launch failed: %s (grid %d)\n", hipGetErrorString(e), gridn);
}
```
